# Optimizing an MI355X kernel written in HIP

```python
import functools
import jax, jax.numpy as jnp
from jax import lax
import numpy as np

D_MODEL = 1024
BATCH = 32
SEQ = 2048
DEPTH = 1
DEC_BATCH = 16
DEC_SEQ = 16
PAST_LEN = 2048

CHUNK = 64
Q_BLOCK = 2 * CHUNK
N_HEADS = 16
HEAD_DIM = D_MODEL // N_HEADS
ATT_W = N_HEADS * HEAD_DIM
D_RNN = D_MODEL
RNN_BLOCKS = 16
RNN_BW = D_RNN // RNN_BLOCKS
CONV_W = 4
RG_C = 8.0
D_FF = ((8 * D_MODEL // 3 + 255) // 256) * 256
N_BRANCH = 2
N_MOD = 9
MACARON_W = 0.5
EPS = 1e-6
FGT_BIAS_INIT = 3.0
IN_COLS = 2 * D_RNN + 3 * ATT_W + N_HEADS + N_BRANCH * D_MODEL
IN_SPLITS = (D_RNN, 2 * D_RNN, 2 * D_RNN + ATT_W, 2 * D_RNN + 2 * ATT_W, 2 * D_RNN + 3 * ATT_W, 2 * D_RNN + 3 * ATT_W + N_HEADS, 2 * D_RNN + 3 * ATT_W + N_HEADS + D_MODEL)

kernel_name = 'hybrid_rglru_fox_macaron_stream_step'


def rms_norm(x, g):
    xf = x.astype(jnp.float32)
    inv = lax.rsqrt(jnp.mean(xf * xf, axis=-1, keepdims=True) + EPS)
    return (xf * inv).astype(x.dtype) * g


def modulate(h, shift, scale):
    return h * (1 + scale[:, None, :]) + shift[:, None, :]


def ada_mod(c, w, b, n):
    m = jax.nn.silu(c) @ w + b
    return m.reshape(c.shape[0], n, D_MODEL)


def swiglu(h, w1, w3, w2):
    return (jax.nn.silu(h @ w1) * (h @ w3)) @ w2


def ffn_sublayer(x, mod, base, g, w1, w3, w2):
    h = modulate(rms_norm(x, g), mod[:, base], mod[:, base + 1])
    gate = 1 + mod[:, base + 2][:, None, :]
    return x + MACARON_W * gate * swiglu(h, w1, w3, w2)


def causal_conv(x, buf, w, b):
    t = x.shape[1]
    xp = jnp.concatenate([buf.astype(x.dtype), x], axis=1)
    y = b + sum(xp[:, j:j + t] * w[j] for j in range(CONV_W))
    return y, xp[:, xp.shape[1] - (CONV_W - 1):]


def block_diag(x, w, b):
    bsz, t, _ = x.shape
    y = jnp.einsum('btni,nij->btnj', x.reshape(bsz, t, RNN_BLOCKS, RNN_BW), w)
    return y.reshape(bsz, t, D_RNN) + b


def rg_lru(x, h0, wa, ba, wx, bx, lam):
    f32 = jnp.float32
    r = jax.nn.sigmoid(block_diag(x, wa, ba).astype(f32))
    i = jax.nn.sigmoid(block_diag(x, wx, bx).astype(f32))
    log_a = -RG_C * r * jax.nn.softplus(-lam.astype(f32))
    a = jnp.exp(log_a)
    u = jnp.sqrt(-jnp.expm1(2.0 * log_a)) * (i * x.astype(f32))

    def step(h, au):
        a_t, u_t = au
        h = a_t * h + u_t
        return h, h

    h_last, hs = lax.scan(step, h0.astype(f32), (jnp.swapaxes(a, 0, 1), jnp.swapaxes(u, 0, 1)))
    return jnp.swapaxes(hs, 0, 1).astype(x.dtype), h_last


def fox_prompt(q, k, v, logf):
    s_len = q.shape[1]
    ft = jnp.swapaxes(jnp.cumsum(logf, axis=1), 1, 2)
    scale = HEAD_DIM ** -0.5
    outs = []
    for blk in range(s_len // Q_BLOCK):
        q0, q1 = blk * Q_BLOCK, (blk + 1) * Q_BLOCK
        s = jnp.einsum('bqhd,bkhd->bhqk', q[:, q0:q1], k[:, :q1]).astype(jnp.float32) * scale
        s = s + ft[:, :, q0:q1, None] - ft[:, :, None, :q1]
        mask = jnp.arange(q1)[None, :] <= jnp.arange(q0, q1)[:, None]
        p = jax.nn.softmax(jnp.where(mask, s, -jnp.inf), axis=-1)
        outs.append(jnp.einsum('bhqk,bkhd->bqhd', p.astype(v.dtype), v[:, :q1]))
    return jnp.concatenate(outs, axis=1)


def fox_sample(q, k, v, logf, cache_k, cache_v, cache_logf):
    past, t = cache_k.shape[1], q.shape[1]
    kk = jnp.concatenate([cache_k.astype(k.dtype), k], axis=1)
    vv = jnp.concatenate([cache_v.astype(v.dtype), v], axis=1)
    lf = jnp.concatenate([cache_logf.astype(jnp.float32), logf], axis=1)
    ft = jnp.swapaxes(jnp.cumsum(lf, axis=1), 1, 2)
    s = jnp.einsum('bqhd,bkhd->bhqk', q, kk).astype(jnp.float32) * (HEAD_DIM ** -0.5)
    s = s + ft[:, :, past:, None] - ft[:, :, None, :]
    mask = jnp.arange(past + t)[None, :] <= (past + jnp.arange(t))[:, None]
    p = jax.nn.softmax(jnp.where(mask, s, -jnp.inf), axis=-1)
    return jnp.einsum('bhqk,bkhd->bqhd', p.astype(vv.dtype), vv)


def mixer_sublayer(x, mod, p, conv_buf, h0, attend):
    bsz, t, _ = x.shape
    h = modulate(rms_norm(x, p['norm']), mod[:, 3], mod[:, 4])
    xr, gr, q, k, v, fl, ga, gb = jnp.split(h @ p['w_in'], IN_SPLITS, axis=-1)
    xc, new_buf = causal_conv(xr, conv_buf, p['conv_w'], p['conv_b'])
    y_rnn, h_last = rg_lru(xc, h0, p['rg_wa'], p['rg_ba'], p['rg_wx'], p['rg_bx'], p['rg_lam'])
    a_out = jax.nn.gelu(gr) * y_rnn
    logf = jax.nn.log_sigmoid(fl.astype(jnp.float32) + p['b_fgt'].astype(jnp.float32))
    heads = (bsz, t, N_HEADS, HEAD_DIM)
    k = k.reshape(heads)
    v = v.reshape(heads)
    att = attend(q.reshape(heads), k, v, logf).reshape(bsz, t, ATT_W)
    z = jax.nn.sigmoid(ga) * (a_out @ p['w_br_rnn']) + jax.nn.sigmoid(gb) * (att @ p['w_br_att'])
    x = x + (1 + mod[:, 5][:, None, :]) * (z @ p['w_out'])
    return x, k, v, logf, new_buf, h_last


def setup_inputs(seed: int = 0) -> dict:
    key = jax.random.key(seed)
    ks = iter(jax.random.split(key, 48))
    f32 = jnp.float32
    L = DEPTH

    def nrm(shape, s):
        return jax.random.normal(next(ks), shape, f32) * s

    x_prompt = nrm((BATCH, SEQ, D_MODEL), 1.0)
    x_sample = nrm((DEC_BATCH, DEC_SEQ, D_MODEL), 1.0)
    cache_k = nrm((L, DEC_BATCH, PAST_LEN, N_HEADS, HEAD_DIM), 1.0)
    cache_v = nrm((L, DEC_BATCH, PAST_LEN, N_HEADS, HEAD_DIM), 1.0)
    cache_logf = jax.nn.log_sigmoid(nrm((L, DEC_BATCH, PAST_LEN, N_HEADS), 1.0) + FGT_BIAS_INIT)
    state_conv = nrm((L, DEC_BATCH, CONV_W - 1, D_RNN), 1.0)
    state_rglru = nrm((L, DEC_BATCH, D_RNN), 0.5)
    c_prompt = nrm((BATCH, D_MODEL), 1.0)
    c_sample = nrm((DEC_BATCH, D_MODEL), 1.0)
    w_ada = nrm((L, D_MODEL, N_MOD * D_MODEL), 0.2 * D_MODEL ** -0.5)
    b_ada = nrm((L, N_MOD * D_MODEL), 0.01)
    ffn1_norm = 1.0 + nrm((L, D_MODEL), 0.02)
    ffn1_w1 = nrm((L, D_MODEL, D_FF), D_MODEL ** -0.5)
    ffn1_w3 = nrm((L, D_MODEL, D_FF), D_MODEL ** -0.5)
    ffn1_w2 = nrm((L, D_FF, D_MODEL), D_FF ** -0.5)
    mix_norm = 1.0 + nrm((L, D_MODEL), 0.02)
    w_in = nrm((L, D_MODEL, IN_COLS), D_MODEL ** -0.5)
    b_fgt = FGT_BIAS_INIT + nrm((L, N_HEADS), 1.0)
    conv_w = nrm((L, CONV_W, D_RNN), CONV_W ** -0.5)
    conv_b = nrm((L, D_RNN), 0.01)
    rg_wa = nrm((L, RNN_BLOCKS, RNN_BW, RNN_BW), RNN_BW ** -0.5)
    rg_ba = nrm((L, D_RNN), 0.01)
    rg_wx = nrm((L, RNN_BLOCKS, RNN_BW, RNN_BW), RNN_BW ** -0.5)
    rg_bx = nrm((L, D_RNN), 0.01)
    a0 = jax.random.uniform(next(ks), (L, D_RNN), f32, 0.9, 0.999)
    pa = a0 ** (1.0 / RG_C)
    rg_lam = jnp.log(pa) - jnp.log1p(-pa)
    w_br_rnn = nrm((L, D_RNN, D_MODEL), D_RNN ** -0.5)
    w_br_att = nrm((L, ATT_W, D_MODEL), ATT_W ** -0.5)
    w_out = nrm((L, D_MODEL, D_MODEL), D_MODEL ** -0.5)
    ffn2_norm = 1.0 + nrm((L, D_MODEL), 0.02)
    ffn2_w1 = nrm((L, D_MODEL, D_FF), D_MODEL ** -0.5)
    ffn2_w3 = nrm((L, D_MODEL, D_FF), D_MODEL ** -0.5)
    ffn2_w2 = nrm((L, D_FF, D_MODEL), D_FF ** -0.5)
    final_norm = 1.0 + nrm((D_MODEL,), 0.02)
    w_ada_f = nrm((D_MODEL, 2 * D_MODEL), 0.2 * D_MODEL ** -0.5)
    b_ada_f = nrm((2 * D_MODEL,), 0.01)
    return {'x_prompt': x_prompt, 'x_sample': x_sample, 'cache_k': cache_k, 'cache_v': cache_v,
            'cache_logf': cache_logf, 'state_conv': state_conv, 'state_rglru': state_rglru,
            'c_prompt': c_prompt, 'c_sample': c_sample, 'w_ada': w_ada, 'b_ada': b_ada,
            'ffn1_norm': ffn1_norm, 'ffn1_w1': ffn1_w1, 'ffn1_w3': ffn1_w3, 'ffn1_w2': ffn1_w2,
            'mix_norm': mix_norm, 'w_in': w_in, 'b_fgt': b_fgt, 'conv_w': conv_w, 'conv_b': conv_b,
            'rg_wa': rg_wa, 'rg_ba': rg_ba, 'rg_wx': rg_wx, 'rg_bx': rg_bx, 'rg_lam': rg_lam,
            'w_br_rnn': w_br_rnn, 'w_br_att': w_br_att, 'w_out': w_out,
            'ffn2_norm': ffn2_norm, 'ffn2_w1': ffn2_w1, 'ffn2_w3': ffn2_w3, 'ffn2_w2': ffn2_w2,
            'final_norm': final_norm, 'w_ada_f': w_ada_f, 'b_ada_f': b_ada_f}


def reference(x_prompt, x_sample, cache_k, cache_v, cache_logf, state_conv, state_rglru,
              c_prompt, c_sample, w_ada, b_ada, ffn1_norm, ffn1_w1, ffn1_w3, ffn1_w2,
              mix_norm, w_in, b_fgt, conv_w, conv_b, rg_wa, rg_ba, rg_wx, rg_bx, rg_lam,
              w_br_rnn, w_br_att, w_out, ffn2_norm, ffn2_w1, ffn2_w3, ffn2_w2,
              final_norm, w_ada_f, b_ada_f):
    xp, xs = x_prompt, x_sample
    bp = x_prompt.shape[0]
    kp_l, vp_l, lp_l, cp_l, hp_l = [], [], [], [], []
    ks_l, vs_l, ls_l, cs_l, hs_l = [], [], [], [], []
    for l in range(DEPTH):
        mp = ada_mod(c_prompt, w_ada[l], b_ada[l], N_MOD)
        ms = ada_mod(c_sample, w_ada[l], b_ada[l], N_MOD)
        xp = ffn_sublayer(xp, mp, 0, ffn1_norm[l], ffn1_w1[l], ffn1_w3[l], ffn1_w2[l])
        xs = ffn_sublayer(xs, ms, 0, ffn1_norm[l], ffn1_w1[l], ffn1_w3[l], ffn1_w2[l])
        p = {'norm': mix_norm[l], 'w_in': w_in[l], 'b_fgt': b_fgt[l], 'conv_w': conv_w[l],
             'conv_b': conv_b[l], 'rg_wa': rg_wa[l], 'rg_ba': rg_ba[l], 'rg_wx': rg_wx[l],
             'rg_bx': rg_bx[l], 'rg_lam': rg_lam[l], 'w_br_rnn': w_br_rnn[l],
             'w_br_att': w_br_att[l], 'w_out': w_out[l]}
        buf0 = jnp.zeros((bp, CONV_W - 1, D_RNN), xp.dtype)
        h00 = jnp.zeros((bp, D_RNN), jnp.float32)
        xp, kp, vp, lp, cp, hp = mixer_sublayer(xp, mp, p, buf0, h00, fox_prompt)
        attend_s = functools.partial(fox_sample, cache_k=cache_k[l], cache_v=cache_v[l],
                                     cache_logf=cache_logf[l])
        xs, ks_, vs_, ls_, cs_, hs_ = mixer_sublayer(xs, ms, p, state_conv[l], state_rglru[l], attend_s)
        xp = ffn_sublayer(xp, mp, 6, ffn2_norm[l], ffn2_w1[l], ffn2_w3[l], ffn2_w2[l])
        xs = ffn_sublayer(xs, ms, 6, ffn2_norm[l], ffn2_w1[l], ffn2_w3[l], ffn2_w2[l])
        kp_l.append(kp); vp_l.append(vp); lp_l.append(lp); cp_l.append(cp); hp_l.append(hp)
        ks_l.append(ks_); vs_l.append(vs_); ls_l.append(ls_); cs_l.append(cs_); hs_l.append(hs_)
    mfp = ada_mod(c_prompt, w_ada_f, b_ada_f, 2)
    mfs = ada_mod(c_sample, w_ada_f, b_ada_f, 2)
    y_prompt = modulate(rms_norm(xp, final_norm), mfp[:, 0], mfp[:, 1])
    y_sample = modulate(rms_norm(xs, final_norm), mfs[:, 0], mfs[:, 1])
    return (y_prompt, y_sample,
            jnp.stack(kp_l), jnp.stack(vp_l), jnp.stack(lp_l), jnp.stack(cp_l), jnp.stack(hp_l),
            jnp.stack(ks_l), jnp.stack(vs_l), jnp.stack(ls_l), jnp.stack(cs_l), jnp.stack(hs_l))
```

```cpp
#include <hip/hip_runtime.h>
#include <hip/hip_cooperative_groups.h>
#include <hip/hip_bf16.h>
#include <cstdio>
#include <cstdint>
#include <cmath>
namespace cg = cooperative_groups;

constexpr int DMODEL = 1024, MP = 65536, MS = 256, MT = MP + MS, SEQ_P = 2048, NB_P = 32, NB_S = 16, TS = 16, PAST = 2048;
constexpr int DFF = 2816, NHEAD = 16, NMOD = 9, INCOLS = 7184;
constexpr int NBT = NB_P + NB_S;
__device__ __forceinline__ int batch_of_row(int r) { return r < MP ? (r >> 11) : NB_P + ((r - MP) >> 4); }

namespace pg8 {
#define PG8_LAS __attribute__((address_space(3)))
typedef unsigned short bf16_t;
typedef short bf16x8 __attribute__((ext_vector_type(8)));
typedef float f32x4 __attribute__((ext_vector_type(4)));
typedef unsigned u32x4 __attribute__((ext_vector_type(4)));
typedef unsigned u32x2 __attribute__((ext_vector_type(2)));
constexpr int BM = 256, BK = 64, HALF = 128, HTB = HALF * BK * 2  , STAGE_BYTES = 8 * HTB, NXCD = 8, WGM = 4;

__host__ __device__ __forceinline__ int lds_byte(int r, int c) { const int st = (r >> 4) * 2 + (c >> 5), rr = r & 15, cc = c & 31, ob = rr * 64 + cc * 2; return st * 1024 + (ob ^ (((ob >> 9) & 1) << 5)); }
__host__ __device__ __forceinline__ void stage_rc(int b, int& R, int& C) { const int st = b / 1024, sb = b % 1024, swz = sb ^ (((sb >> 9) & 1) << 5); R = (st >> 1) * 16 + swz / 64; C = (st & 1) * 32 + (swz % 64) / 2; }
__host__ __device__ __forceinline__ int perm32(int rho) { const int n = rho >> 4, i = rho & 15; return 8 * (i >> 2) + 4 * n + (i & 3); }

struct Unit { int pm, pn; };
struct Gemm { const bf16_t* A; const bf16_t* Bt; int M, N, K; };

struct StaticOrder {
    int nM, nN, nwg, G, c;
    __host__ __device__ void init(int M, int N, int G_, int c_) { nM = M / BM; nN = N / BM; nwg = nM * nN; G = G_; c = c_; }
    __host__ __device__ bool next(int i, Unit& u) const {
        const long L = (long)i * G + c; if (L >= nwg) return false;
        int wgid = (int)L; { const int q = nwg / NXCD, r = nwg % NXCD, xcd = wgid % NXCD, off = wgid / NXCD; wgid = (xcd < r ? xcd * (q + 1) : r * (q + 1) + (xcd - r) * q) + off; }
        const int nig = WGM * nN, gid = wgid / nig, fm = gid * WGM, gsz = (nM - fm) < WGM ? (nM - fm) : WGM;
        u.pm = fm + ((wgid % nig) % gsz); u.pn = (wgid % nig) / gsz; return true;
    }
    __device__ __forceinline__ void a_ready(const Unit&) const {}
    __device__ __forceinline__ void done(const Unit&) const {}
};

typedef float f32x2c_t __attribute__((ext_vector_type(2))); typedef __bf16 bf16x2c_t __attribute__((ext_vector_type(2)));
__device__ __forceinline__ unsigned cvt_pk_bf16(float lo, float hi) { const f32x2c_t v = {lo, hi}; const bf16x2c_t b = __builtin_convertvector(v, bf16x2c_t); return __builtin_bit_cast(unsigned, b); }
__device__ __forceinline__ float bf_lo(unsigned w) { return __uint_as_float(w << 16); }
__device__ __forceinline__ float bf_hi(unsigned w) { return __uint_as_float(w & 0xffff0000u); }
__device__ __forceinline__ float sigmoid_f(float x) { return __builtin_amdgcn_rcpf(1.0f + __builtin_amdgcn_exp2f(-1.4426950408889634f * x)); }
__device__ __forceinline__ float silu_f(float x) { return x * sigmoid_f(x); }
__device__ __forceinline__ float gelu_tanh_f(float x) { const float y = 1.5957691216057308f * (x + 0.044715f * x * x * x); return x * sigmoid_f(y); }
__device__ __forceinline__ u32x4 pack8(f32x4 a, f32x4 b) { u32x4 w; w.x = cvt_pk_bf16(a[0], a[1]); w.y = cvt_pk_bf16(a[2], a[3]); w.z = cvt_pk_bf16(b[0], b[1]); w.w = cvt_pk_bf16(b[2], b[3]); return w; }
__device__ __forceinline__ int epi_batch(const Unit& u, int ai, int wr, int m) { return u.pm < 256 ? (u.pm >> 3) : NB_P + 8 * ai + 4 * wr + m; }

__device__ __forceinline__ unsigned gate4(f32x4 v) { unsigned w = 0;
#pragma unroll
    for (int i = 0; i < 4; ++i) w |= (unsigned)(sigmoid_f(v[i]) * 255.0f + 0.5f) << (8 * i);
    return w; }
__device__ __forceinline__ f32x4 ungate4(unsigned w) { return (f32x4){(float)(w & 255u), (float)((w >> 8) & 255u), (float)((w >> 16) & 255u), (float)(w >> 24)} * (1.0f / 255.0f); }
struct EpiSwiglu {
    static constexpr bool PERM = true, AFTER_DRAIN = false, DEADCOLS = false;
    bf16_t* G;
    __device__ __forceinline__ void operator()(const f32x4 (&acc)[2][2][4][2], const Unit& u, int wr, int wc, int fr, int fq) const {
        const int row0 = u.pm * BM + wr * 64 + fr, col0 = u.pn * HALF + wc * 32 + 8 * fq;
#pragma unroll
        for (int ai = 0; ai < 2; ++ai)
#pragma unroll
            for (int m = 0; m < 4; ++m) { bf16_t* rowp = G + (size_t)(row0 + ai * HALF + m * 16) * DFF + col0;
                const f32x4 a0 = acc[ai][0][m][0], a1 = acc[ai][0][m][1], b0 = acc[ai][1][m][0], b1 = acc[ai][1][m][1];
                f32x4 v0, v1;
#pragma unroll
                for (int i = 0; i < 4; ++i) { v0[i] = silu_f(a0[i]) * b0[i]; v1[i] = silu_f(a1[i]) * b1[i]; }
                *(u32x4*)rowp = pack8(v0, v1); }
    }
};

template <bool WF32> struct EpiResid {
    static constexpr bool PERM = true, AFTER_DRAIN = false, DEADCOLS = false;
    const float* base; float* out; const float* mod; int jmod; float mult; bf16_t* XB;
    __device__ __forceinline__ void operator()(const f32x4 (&acc)[2][2][4][2], const Unit& u, int wr, int wc, int fr, int fq) const {
        const int col0 = u.pn * BM + wc * 32 + 8 * fq; const float* mp = mod + (size_t)(u.pm >> 3) * (NMOD * DMODEL) + jmod * DMODEL + col0;
#pragma unroll
        for (int ai = 0; ai < 2; ++ai)
#pragma unroll
            for (int m = 0; m < 4; ++m) { const size_t ro = (size_t)(u.pm * BM + ai * HALF + wr * 64 + m * 16 + fr) * DMODEL + col0;
#pragma unroll
                for (int bj = 0; bj < 2; ++bj) { const int o = bj * HALF;
                    const f32x4 o0 = *(const f32x4*)(base + ro + o) + (*(const f32x4*)(mp + o) + 1.0f) * mult * acc[ai][bj][m][0];
                    const f32x4 o1 = *(const f32x4*)(base + ro + o + 4) + (*(const f32x4*)(mp + o + 4) + 1.0f) * mult * acc[ai][bj][m][1];
                    if (WF32) { *(f32x4*)(out + ro + o) = o0; *(f32x4*)(out + ro + o + 4) = o1; }
                    *(u32x4*)(XB + ro + o) = pack8(o0, o1); } }
    }
};

struct EpiIn {
    static constexpr bool PERM = true, AFTER_DRAIN = false, DEADCOLS = true;
    __device__ __forceinline__ static bool live(const Unit& u, int bj, int wc) { return u.pn != 20 || (bj == 0 && wc == 0); }
    bf16_t *XR, *GR, *Q, *K, *V; float* dout; const float* bfgt; float qscale; unsigned char *GA8, *GB8;
    __device__ __forceinline__ void operator()(const f32x4 (&acc)[2][2][4][2], const Unit& u, int wr, int wc, int fr, int fq) const {
        if (u.pn >= 21) {
            const int gi = u.pn - 21; unsigned char* dst = (gi < 4) ? GA8 : GB8; const int c0 = (gi & 3) * BM + wc * 32 + 8 * fq;
#pragma unroll
            for (int ai = 0; ai < 2; ++ai)
#pragma unroll
                for (int m = 0; m < 4; ++m) { unsigned char* rowp = dst + (size_t)(u.pm * BM + ai * HALF + wr * 64 + m * 16 + fr) * DMODEL + c0;
#pragma unroll
                    for (int bj = 0; bj < 2; ++bj) *(u32x2*)(rowp + bj * HALF) = (u32x2){gate4(acc[ai][bj][m][0]), gate4(acc[ai][bj][m][1])}; }
            return; }
        const int reg = u.pn >> 2, colt = (u.pn & 3) * BM, col0 = colt + wc * 32 + 8 * fq;
        if (u.pn == 20) {
            if (wc == 0 && fq < 2) {
#pragma unroll
                for (int ai = 0; ai < 2; ++ai)
#pragma unroll
                    for (int m = 0; m < 4; ++m) { const int row = u.pm * BM + ai * HALF + wr * 64 + m * 16 + fr;
                        float* lp = dout + (row < MP ? (size_t)201588736 + (size_t)row * NHEAD : (size_t)203292672 + (size_t)(row - MP) * NHEAD) + 8 * fq;
#pragma unroll
                        for (int n = 0; n < 2; ++n) { f32x4 x = acc[ai][0][m][n] + *(const f32x4*)(bfgt + 8 * fq + 4 * n), o;
#pragma unroll
                            for (int i = 0; i < 4; ++i) o[i] = fminf(x[i], 0.f) - log1pf(__expf(-fabsf(x[i])));
                            *(f32x4*)(lp + 4 * n) = o; } }
            }
            return;
        }
        bf16_t* dst = reg == 0 ? XR : reg == 1 ? GR : reg == 2 ? Q : reg == 3 ? K : V;
#pragma unroll
        for (int ai = 0; ai < 2; ++ai)
#pragma unroll
            for (int m = 0; m < 4; ++m) { const int row = u.pm * BM + ai * HALF + wr * 64 + m * 16 + fr; bf16_t* rowp = dst + (size_t)row * DMODEL + col0;
#pragma unroll
                for (int bj = 0; bj < 2; ++bj) { f32x4 v0 = acc[ai][bj][m][0], v1 = acc[ai][bj][m][1];
                    if (reg == 1) {
#pragma unroll
                        for (int i = 0; i < 4; ++i) { v0[i] = gelu_tanh_f(v0[i]); v1[i] = gelu_tanh_f(v1[i]); } }
                    else if (reg == 2) { v0 = v0 * qscale; v1 = v1 * qscale; }
                    else if (reg >= 3) {
                        float* op = dout + (reg == 3 ? (row < MP ? (size_t)67371008 : (size_t)202768384) : (row < MP ? (size_t)134479872 : (size_t)203030528))
                                    + (size_t)(row < MP ? row : row - MP) * DMODEL + col0 + bj * HALF;
                        *(f32x4*)op = v0; *(f32x4*)(op + 4) = v1; }
                    else {
                        int t, b; if (row < MP) { t = (row & 2047) - 2045; b = row >> 11; } else { t = ((row - MP) & 15) - 13; b = (row - MP) >> 4; }
                        if (t >= 0) { float* op = dout + (row < MP ? (size_t)202637312 : (size_t)203296768) + ((size_t)b * 3 + t) * DMODEL + col0 + bj * HALF;
                            *(f32x4*)op = v0; *(f32x4*)(op + 4) = v1; } }
                    *(u32x4*)(rowp + bj * HALF) = pack8(v0, v1); } }
    }
};

template <bool ADD> struct EpiZ {
    static constexpr bool PERM = true, AFTER_DRAIN = false, DEADCOLS = false;
    const unsigned char* GATE; bf16_t* Z;
    __device__ __forceinline__ void operator()(const f32x4 (&acc)[2][2][4][2], const Unit& u, int wr, int wc, int fr, int fq) const {
        const int col0 = u.pn * BM + wc * 32 + 8 * fq;
#pragma unroll
        for (int ai = 0; ai < 2; ++ai)
#pragma unroll
            for (int m = 0; m < 4; ++m) { const int row = u.pm * BM + ai * HALF + wr * 64 + m * 16 + fr; const size_t off = (size_t)row * DMODEL + col0;
#pragma unroll
                for (int bj = 0; bj < 2; ++bj) { const u32x2 g = *(const u32x2*)(GATE + off + bj * HALF); f32x4 v0 = acc[ai][bj][m][0] * ungate4(g.x), v1 = acc[ai][bj][m][1] * ungate4(g.y);
                    if (ADD) { const u32x4 z = *(const u32x4*)(Z + off + bj * HALF);
                        v0[0] += bf_lo(z.x); v0[1] += bf_hi(z.x); v0[2] += bf_lo(z.y); v0[3] += bf_hi(z.y); v1[0] += bf_lo(z.z); v1[1] += bf_hi(z.z); v1[2] += bf_lo(z.w); v1[3] += bf_hi(z.w); }
                    *(u32x4*)(Z + off + bj * HALF) = pack8(v0, v1); } }
    }
};

template <class Epi, class Sched, bool ALIGN_EPI = false, bool SP2 = false>
__device__ __forceinline__ void gemm_phase(PG8_LAS unsigned char* lds, const Gemm g, const Sched& S, const Epi& E, const int tid) {
    const int wid = __builtin_amdgcn_readfirstlane(tid >> 6), lane = tid & 63, wr = wid >> 2, wc = wid & 3, fr = lane & 15, fq = lane >> 4;
    const int K = g.K, nt = K / BK;
    unsigned voffA[2], voffB[2];
#pragma unroll
    for (int i = 0; i < 2; ++i) { int R, C; stage_rc(tid * 16 + i * 8192, R, C); const int Rb = Epi::PERM ? ((R & ~31) + perm32(R & 31)) : R;
        voffA[i] = (unsigned)(R * K + C) * 2u; voffB[i] = (unsigned)(Rb * K + C) * 2u; }
    const size_t kstep = (size_t)(BK * 2);
    const size_t hstep = (size_t)HALF * K * 2;
    const size_t tstep = 2 * hstep;
    const unsigned ldsw = (unsigned)wid * 1024u;
    const int aoff = lds_byte(wr * 64 + fr, fq * 8), boff = lds_byte(wc * 32 + fr, fq * 8);
#define PG8_SA(b, h) (((b) * 2 + (h)) * HTB)
#define PG8_SB(b, h) ((4 + (b) * 2 + (h)) * HTB)
#define PG8_STAGE(bufoff, gbase, voff) do { _Pragma("unroll") for (int _i = 0; _i < 2; ++_i) \
        __builtin_amdgcn_global_load_lds((const unsigned*)((const char*)(gbase) + (voff)[_i]), (PG8_LAS unsigned*)(lds + (bufoff) + ldsw + _i * 8192), 16, 0, 0); } while (0)
#define PG8_LDA(dst, b, h) do { _Pragma("unroll") for (int m = 0; m < 4; ++m) _Pragma("unroll") for (int k = 0; k < 2; ++k) dst[m][k] = *(const PG8_LAS bf16x8*)(lds + PG8_SA(b, h) + aoff + m * 2048 + k * 1024); } while (0)
#define PG8_LDB(dst, b, h) do { _Pragma("unroll") for (int n = 0; n < 2; ++n) _Pragma("unroll") for (int k = 0; k < 2; ++k) dst[n][k] = *(const PG8_LAS bf16x8*)(lds + PG8_SB(b, h) + boff + n * 2048 + k * 1024); } while (0)
#define PG8_MMA(ai, bj, At, Bt) do { if (bj ? lv1 : lv0) { __builtin_amdgcn_s_setprio(1); _Pragma("unroll") for (int m = 0; m < 4; ++m) _Pragma("unroll") for (int n = 0; n < 2; ++n) _Pragma("unroll") for (int k = 0; k < 2; ++k) \
        acc[ai][bj][m][n] = __builtin_amdgcn_mfma_f32_16x16x32_bf16(Bt[n][k], At[m][k], acc[ai][bj][m][n], 0, 0, 0); __builtin_amdgcn_s_setprio(0); } } while (0)
#define PG8_WAIT_V(n) asm volatile("s_waitcnt vmcnt(" #n ")" ::: "memory")
#define PG8_WAIT_L(n) asm volatile("s_waitcnt lgkmcnt(" #n ")" ::: "memory")
#define PG8_BAR __builtin_amdgcn_s_barrier()
#define PG8_SCHED __builtin_amdgcn_sched_barrier(0)
    Unit cur, nxt; int ui = 0;
    if (!S.next(0, cur)) return;
    bool lv0 = true, lv1 = true; if constexpr (Epi::DEADCOLS) { lv0 = Epi::live(cur, 0, wc); lv1 = Epi::live(cur, 1, wc); }
    f32x4 acc[2][2][4][2];
#pragma unroll
    for (int a = 0; a < 2; ++a)
#pragma unroll
        for (int b = 0; b < 2; ++b)
#pragma unroll
            for (int m = 0; m < 4; ++m)
#pragma unroll
                for (int n = 0; n < 2; ++n) acc[a][b][m][n] = (f32x4){0.f, 0.f, 0.f, 0.f};
    bf16x8 At[4][2], B0[2][2], B1[2][2];
    const char* cA = (const char*)g.A + (size_t)cur.pm * tstep; const char* cB = (const char*)g.Bt + (size_t)cur.pn * tstep;
    S.a_ready(cur);
    if constexpr (SP2) {
        PG8_STAGE(PG8_SB(0, 0), cB, voffB); PG8_STAGE(PG8_SB(0, 1), cB + hstep, voffB); PG8_STAGE(PG8_SA(0, 0), cA, voffA); PG8_STAGE(PG8_SA(0, 1), cA + hstep, voffA);
        if (wr == 1) PG8_BAR;
        PG8_WAIT_V(2); PG8_BAR;
        PG8_STAGE(PG8_SB(1, 0), cB + kstep, voffB); PG8_STAGE(PG8_SA(1, 0), cA + kstep, voffA); PG8_STAGE(PG8_SB(1, 1), cB + hstep + kstep, voffB);
        PG8_WAIT_V(6); PG8_BAR;
    } else {
        PG8_STAGE(PG8_SB(0, 0), cB, voffB); PG8_STAGE(PG8_SA(0, 0), cA, voffA); PG8_STAGE(PG8_SB(0, 1), cB + hstep, voffB); PG8_STAGE(PG8_SA(0, 1), cA + hstep, voffA);
        if (wr == 1) PG8_BAR;
        PG8_WAIT_V(4); PG8_BAR;
        PG8_STAGE(PG8_SB(1, 0), cB + kstep, voffB); PG8_STAGE(PG8_SA(1, 0), cA + kstep, voffA); PG8_STAGE(PG8_SB(1, 1), cB + hstep + kstep, voffB);
        PG8_WAIT_V(6); PG8_BAR;
    }
    for (;;) {
        const bool has_next = S.next(ui + 1, nxt);
        const char* nA = has_next ? (const char*)g.A + (size_t)nxt.pm * tstep : cA; const char* nB = has_next ? (const char*)g.Bt + (size_t)nxt.pn * tstep : cB;
        for (int t = 0; t < nt; t += 2) {
            const bool last = (t == nt - 2);
            const char* a1 = cA + (size_t)(t + 1) * kstep;
            const char* a2 = last ? nA : cA + (size_t)(t + 2) * kstep; const char* b2 = last ? nB : cB + (size_t)(t + 2) * kstep;
            const char* a3 = a2 + kstep; const char* b3 = b2 + kstep;
            if (last && has_next) S.a_ready(nxt);
            if constexpr (SP2) {
            PG8_LDB(B0, 0, 0); PG8_LDB(B1, 0, 1); PG8_SCHED; PG8_LDA(At, 0, 0); PG8_STAGE(PG8_SA(1, 1), a1 + hstep, voffA);
            PG8_WAIT_V(8); PG8_WAIT_L(0); PG8_BAR; PG8_MMA(0, 0, At, B0); PG8_MMA(0, 1, At, B1); PG8_BAR; PG8_SCHED;
            PG8_LDA(At, 0, 1); PG8_STAGE(PG8_SB(0, 0), b2, voffB); PG8_STAGE(PG8_SB(0, 1), b2 + hstep, voffB); PG8_STAGE(PG8_SA(0, 0), a2, voffA);
            PG8_WAIT_V(8); PG8_WAIT_L(0); PG8_BAR; PG8_MMA(1, 0, At, B0); PG8_MMA(1, 1, At, B1); PG8_BAR; PG8_SCHED;
            PG8_LDB(B0, 1, 0); PG8_LDB(B1, 1, 1); PG8_SCHED; PG8_LDA(At, 1, 0); PG8_STAGE(PG8_SA(0, 1), a2 + hstep, voffA);
            PG8_WAIT_V(8); PG8_WAIT_L(0); PG8_BAR; PG8_MMA(0, 0, At, B0); PG8_MMA(0, 1, At, B1); PG8_BAR; PG8_SCHED;
            PG8_LDA(At, 1, 1); PG8_STAGE(PG8_SB(1, 0), b3, voffB); PG8_STAGE(PG8_SB(1, 1), b3 + hstep, voffB); PG8_STAGE(PG8_SA(1, 0), a3, voffA);
            PG8_WAIT_V(8); PG8_WAIT_L(0); PG8_BAR; PG8_MMA(1, 0, At, B0); PG8_MMA(1, 1, At, B1); PG8_BAR; PG8_SCHED;
            } else {
            PG8_LDB(B0, 0, 0); PG8_SCHED; PG8_LDA(At, 0, 0); PG8_STAGE(PG8_SA(1, 1), a1 + hstep, voffA);
            PG8_WAIT_L(8); PG8_BAR; PG8_WAIT_L(0); PG8_MMA(0, 0, At, B0); PG8_BAR; PG8_SCHED;
            PG8_LDB(B1, 0, 1); PG8_STAGE(PG8_SB(0, 0), b2, voffB);
            PG8_BAR; PG8_WAIT_L(0); PG8_MMA(0, 1, At, B1); PG8_BAR;
            PG8_LDA(At, 0, 1); PG8_STAGE(PG8_SA(0, 0), a2, voffA);
            PG8_BAR; PG8_WAIT_L(0); PG8_MMA(1, 0, At, B0); PG8_BAR; PG8_SCHED;
            PG8_STAGE(PG8_SB(0, 1), b2 + hstep, voffB);
            PG8_WAIT_V(6); PG8_BAR; PG8_MMA(1, 1, At, B1); PG8_BAR;
            PG8_LDB(B0, 1, 0); PG8_SCHED; PG8_LDA(At, 1, 0); PG8_STAGE(PG8_SA(0, 1), a2 + hstep, voffA);
            PG8_WAIT_L(8); PG8_BAR; PG8_WAIT_L(0); PG8_MMA(0, 0, At, B0); PG8_BAR; PG8_SCHED;
            PG8_LDB(B1, 1, 1); PG8_STAGE(PG8_SB(1, 0), b3, voffB);
            PG8_BAR; PG8_WAIT_L(0); PG8_MMA(0, 1, At, B1); PG8_BAR;
            PG8_LDA(At, 1, 1); PG8_STAGE(PG8_SA(1, 0), a3, voffA);
            PG8_BAR; PG8_WAIT_L(0); PG8_MMA(1, 0, At, B0); PG8_BAR; PG8_SCHED;
            PG8_STAGE(PG8_SB(1, 1), b3 + hstep, voffB);
            PG8_WAIT_V(6); PG8_BAR; PG8_MMA(1, 1, At, B1); PG8_BAR;
            }
        }
        if constexpr (ALIGN_EPI) { if (wr == 0) PG8_BAR; }
        if constexpr (!Epi::AFTER_DRAIN) { E(acc, cur, wr, wc, fr, fq); S.done(cur); }
        if (!has_next) break;
#pragma unroll
        for (int a = 0; a < 2; ++a)
#pragma unroll
            for (int b = 0; b < 2; ++b)
#pragma unroll
                for (int m = 0; m < 4; ++m)
#pragma unroll
                    for (int n = 0; n < 2; ++n) acc[a][b][m][n] = (f32x4){0.f, 0.f, 0.f, 0.f};
        cur = nxt; cA = nA; cB = nB; ++ui;
        if constexpr (Epi::DEADCOLS) { lv0 = Epi::live(cur, 0, wc); lv1 = Epi::live(cur, 1, wc); }
        if constexpr (ALIGN_EPI) { if (wr == 1) PG8_BAR; }
    }
    PG8_WAIT_V(0);
    if constexpr (!ALIGN_EPI) { if (wr == 0) PG8_BAR; }
    PG8_BAR;
    if constexpr (Epi::AFTER_DRAIN) { E.fused(acc, cur, wr, wc, fr, fq, lds, wid, lane); S.done(cur); }
#undef PG8_SA
#undef PG8_SB
#undef PG8_STAGE
#undef PG8_LDA
#undef PG8_LDB
#undef PG8_MMA
#undef PG8_WAIT_V
#undef PG8_WAIT_L
#undef PG8_BAR
#undef PG8_SCHED
}
}

namespace attn_body {
using bf16=__hip_bfloat16;
using bf16x8=__attribute__((ext_vector_type(8)))short;
using s16x4=__attribute__((ext_vector_type(4)))short;
using f32x16=__attribute__((ext_vector_type(16)))float;
using u32x4=__attribute__((ext_vector_type(4)))unsigned;
using f32x4v=__attribute__((ext_vector_type(4)))float;
constexpr int BATCH=32,NHEAD=16,SEQ=2048,D=64,DM=NHEAD*D;
constexpr int NW=8,QBLK=32,QB=QBLK*NW,KVBLK=64,NQB=SEQ/QB;
constexpr int ATTN_PITCH=DM, ATTN_UNIT_ROWS=QB;
__device__ __forceinline__ int crow(int r,int hi){return (r&3)+8*(r>>2)+4*hi;}
#define SBAR() __builtin_amdgcn_sched_barrier(0)
__device__ __forceinline__ void cmask(f32x16&p0,f32x16&p1,int jb,int qrel,int hi){
  asm volatile("":"+v"(hi));
  const float NEG=-INFINITY; int kb=64*jb+4*hi;
  #pragma unroll
  for(int r=0;r<16;++r){int kv=kb+(r&3)+8*(r>>2); if(kv>qrel)p0[r]=NEG; if(kv+32>qrel)p1[r]=NEG;}
}

constexpr int NSLOT=3, SLOTB=8192;
constexpr int LDS_K=0, LDS_V=NSLOT*SLOTB, LDS_WS=2*NSLOT*SLOTB, LDS_OST=LDS_WS+NW*64*4, LDS_BYTES=LDS_OST+NW*4096;
constexpr int LDS_NF=86016, LDS_NFW=LDS_NF+8192;
constexpr float C2=0.125f*1.4426950408889634f;
__device__ __forceinline__ void glds16(const void*gsrc,unsigned lds_dst){unsigned keep;
  asm volatile("s_mov_b32 %0, m0\n\ts_mov_b32 m0, %2\n\ts_nop 0\n\tglobal_load_lds_dwordx4 %1, off\n\ts_mov_b32 m0, %0":"=&s"(keep):"v"(gsrc),"s"(lds_dst):"memory");}
__device__ __forceinline__ float max3f(float a,float b,float c){float r;asm("v_max3_f32 %0, %1, %2, %3":"=v"(r):"v"(a),"v"(b),"v"(c));return r;}
__device__ __forceinline__ float max2f(float a,float b){float r;asm("v_max_f32_e32 %0, %1, %2":"=v"(r):"v"(a),"v"(b));return r;}
__device__ __forceinline__ float fadd_s(float a,float b){float r;asm("v_add_f32_e32 %0, %1, %2":"=v"(r):"v"(a),"v"(b));return r;}
__device__ __forceinline__ float fsub_s(float a,float b){float r;asm("v_sub_f32_e32 %0, %1, %2":"=v"(r):"v"(a),"v"(b));return r;}
typedef float f32x2_t __attribute__((ext_vector_type(2))); typedef __bf16 bf16x2_t __attribute__((ext_vector_type(2)));
__device__ __forceinline__ unsigned cvtpk_s(float lo,float hi){f32x2_t v={lo,hi};bf16x2_t b=__builtin_convertvector(v,bf16x2_t);return __builtin_bit_cast(unsigned,b);}
#define WAIT_BAR(N) asm volatile("s_waitcnt vmcnt(" #N ") lgkmcnt(0)\n\ts_barrier":::"memory")

__device__ __forceinline__ void qkt(f32x16&p0,f32x16&p1,const char*Kslot,const bf16x8*qr,const f32x16&negm,int r32,int hi){
  const char*kb=Kslot+hi*1024+r32*16;
  #pragma unroll
  for(int d0=0;d0<4;++d0){
    const bf16x8 b0=*reinterpret_cast<const bf16x8*>(kb+d0*2048);
    const bf16x8 b1=*reinterpret_cast<const bf16x8*>(kb+d0*2048+512);
    if(d0==0){p0=__builtin_amdgcn_mfma_f32_32x32x16_bf16(b0,qr[0],negm,0,0,0);p1=__builtin_amdgcn_mfma_f32_32x32x16_bf16(b1,qr[0],negm,0,0,0);}
    else{p0=__builtin_amdgcn_mfma_f32_32x32x16_bf16(b0,qr[d0],p0,0,0,0);p1=__builtin_amdgcn_mfma_f32_32x32x16_bf16(b1,qr[d0],p1,0,0,0);}}
}
typedef __attribute__((address_space(3))) const char* lds_cptr;
typedef short v4i16_t __attribute__((ext_vector_type(4)));
__device__ __forceinline__ void kload8(bf16x8*kf,lds_cptr kp){
  kf[0]=*(const __attribute__((address_space(3))) bf16x8*)(kp);      kf[1]=*(const __attribute__((address_space(3))) bf16x8*)(kp+512);
  kf[2]=*(const __attribute__((address_space(3))) bf16x8*)(kp+2048); kf[3]=*(const __attribute__((address_space(3))) bf16x8*)(kp+2560);
  kf[4]=*(const __attribute__((address_space(3))) bf16x8*)(kp+4096); kf[5]=*(const __attribute__((address_space(3))) bf16x8*)(kp+4608);
  kf[6]=*(const __attribute__((address_space(3))) bf16x8*)(kp+6144); kf[7]=*(const __attribute__((address_space(3))) bf16x8*)(kp+6656);
}
__device__ __forceinline__ void kload2(bf16x8*kf,lds_cptr kp,int j){ kf[2*j]=*(const __attribute__((address_space(3))) bf16x8*)(kp+j*2048); kf[2*j+1]=*(const __attribute__((address_space(3))) bf16x8*)(kp+j*2048+512); }
__device__ __forceinline__ s16x4 vtr(lds_cptr p){ return __builtin_bit_cast(s16x4,__builtin_amdgcn_ds_read_tr16_b64_v4i16((__attribute__((address_space(3))) v4i16_t*)p)); }
__device__ __forceinline__ float rowmax(const f32x16&p0,const f32x16&p1){
  float a=max3f(p0[0],p0[1],p1[0]),b=max3f(p0[2],p0[3],p1[1]);a=max3f(a,p1[2],p1[3]);
  #pragma unroll
  for(int r=4;r<16;r+=4){a=max3f(a,p0[r],p0[r+1]);b=max3f(b,p0[r+2],p0[r+3]);a=max3f(a,p1[r],p1[r+1]);b=max3f(b,p1[r+2],p1[r+3]);}
  const float m=max2f(a,b);
  auto rr=__builtin_amdgcn_permlane32_swap(__float_as_uint(m),__float_as_uint(m),false,false);
  return max2f(__uint_as_float(rr[0]),__uint_as_float(rr[1]));
}
__device__ __forceinline__ void pv(f32x16*o,int vb,bf16x8 pa0,bf16x8 pa1,bf16x8 pa2,bf16x8 pa3){
  #pragma unroll
  for(int d0=0;d0<2;++d0){s16x4 lo[4],hi[4];
    #pragma unroll
    for(int ks=0;ks<4;++ks){
      asm volatile("ds_read_b64_tr_b16 %0,%1 offset:%c2":"=&v"(lo[ks]):"v"(vb),"i"(d0*4096+ks*1024):"memory");
      asm volatile("ds_read_b64_tr_b16 %0,%1 offset:%c2":"=&v"(hi[ks]):"v"(vb),"i"(d0*4096+ks*1024+512):"memory");}
    asm volatile("s_waitcnt lgkmcnt(0)":::"memory");SBAR();
    #define PK(k) (bf16x8){lo[k][0],lo[k][1],lo[k][2],lo[k][3],hi[k][0],hi[k][1],hi[k][2],hi[k][3]}
    o[d0]=__builtin_amdgcn_mfma_f32_32x32x16_bf16(pa0,PK(0),o[d0],0,0,0);
    o[d0]=__builtin_amdgcn_mfma_f32_32x32x16_bf16(pa1,PK(1),o[d0],0,0,0);
    o[d0]=__builtin_amdgcn_mfma_f32_32x32x16_bf16(pa2,PK(2),o[d0],0,0,0);
    o[d0]=__builtin_amdgcn_mfma_f32_32x32x16_bf16(pa3,PK(3),o[d0],0,0,0);
    #undef PK
  }
}

#ifndef ATTN_STORE16
#define ATTN_STORE16(p,v) (*(u32x4*)(p)=(v))
#endif
template<int THRL> __device__ __forceinline__ void attn_unit(int b,int h,int qb,const bf16*Q,const bf16*__restrict__ K,const bf16*__restrict__ V,bf16*O,char*shm,int tid_){
  asm volatile("":"+v"(tid_));
  const int tid=tid_,lane=tid&63,r32=lane&31,hi=lane>>5; const int wid=__builtin_amdgcn_readfirstlane(tid>>6);
  const long rowbase=(long)b*SEQ; const int q0=qb*QB;
  const bf16*Qw=Q+(rowbase+q0+wid*QBLK)*DM+h*D;
  const bf16*Kh=K+rowbase*DM+h*D,*Vh=V+rowbase*DM+h*D;
  const unsigned lds0=(unsigned)(uintptr_t)shm;
  float*wsf=(float*)(shm+LDS_WS)+wid*64;
  const bf16*ksrc=Kh+(long)lane*DM+wid*8;
  const bf16*vsrc=Vh+(long)(16*(wid&3)+(lane>>2))*DM+(wid>>2)*32+(lane&3)*8;
  const unsigned kdst=lds0+LDS_K+wid*1024, vdst=lds0+LDS_V+wid*1024;
  #define DMA_K(t,slot) glds16(ksrc+(long)(t)*KVBLK*DM,(unsigned)__builtin_amdgcn_readfirstlane(kdst+(slot)))
  #define DMA_V(t,slot) glds16(vsrc+(long)(t)*KVBLK*DM,(unsigned)__builtin_amdgcn_readfirstlane(vdst+(slot)))
  const int vb0=(int)(lds0+LDS_V)+((lane>>4)&1)*32+(lane&3)*8+(4*hi+((lane&15)>>2))*64;
  const char*Kbase=shm+LDS_K; bf16x8 kf[8];
  const lds_cptr shm3=(lds_cptr)shm; const lds_cptr kp0=shm3+LDS_K+hi*1024+r32*16; const lds_cptr vp0=shm3+LDS_V+((lane>>4)&1)*32+(lane&3)*8+(4*hi+((lane&15)>>2))*64;
  const int NT=(q0+QB)/KVBLK;
  DMA_K(0,0);DMA_V(0,0);DMA_K(1,SLOTB);
  bf16x8 qr[4];
  #pragma unroll
  for(int d0=0;d0<4;++d0)qr[d0]=*reinterpret_cast<const bf16x8*>(&Qw[(long)r32*DM+d0*16+hi*8]);
  float mhat=0.f,l_reg=0.f;f32x16 o[2]; { float z_=0.f; asm volatile("":"+v"(z_));
    _Pragma("unroll") for(int r=0;r<16;++r){o[0][r]=z_;o[1][r]=z_;} }
  const f32x16 negm=f32x16{};
  const int qrel=wid*QBLK+r32;
  const __attribute__((address_space(3))) char* shm3n=(const __attribute__((address_space(3))) char*)shm;
  #define CMASK(P0,P1,t) do{int jb_=(t)-(NT-4); if(jb_>=0)cmask(P0,P1,jb_,qrel,hi);}while(0)
  const __attribute__((address_space(3))) f32x4v* nfp=(const __attribute__((address_space(3))) f32x4v*)(shm3n+LDS_NF)+hi;
  #define BIAS(P0,P1,t) do{ _Pragma("unroll") for(int a_=0;a_<4;++a_){ const f32x4v b0_=nfp[16*(t)+2*a_], b1_=nfp[16*(t)+2*a_+8]; \
      _Pragma("unroll") for(int i_=0;i_<4;++i_){ P0[4*a_+i_]+=(b0_[i_]-mhat); P1[4*a_+i_]+=(b1_[i_]-mhat); } } }while(0)
  bool resc=false;
  #define START(P0,P1) do{ const float rm=rowmax(P0,P1); resc=false; \
    { const float dl=rm; mhat=fadd_s(mhat,dl); \
      _Pragma("unroll") for(int r=0;r<16;++r){P0[r]=fsub_s(P0[r],dl);P1[r]=fsub_s(P1[r],dl);} \
      } \
    _Pragma("unroll") for(int r=0;r<16;++r)P0[r]=__builtin_amdgcn_exp2f(P0[r]); }while(0)
  #define RESC() do{ if(resc){ asm volatile("s_waitcnt lgkmcnt(0)":::"memory"); \
      _Pragma("unroll") for(int d_=0;d_<2;++d_) _Pragma("unroll") for(int r=0;r<16;++r)o[d_][r]*=wsf[crow(r,hi)]; } }while(0)
  f32x16 pA0,pA1,pB0,pB1;
  int sl_prev=0,sl_cur=0,sl_next=SLOTB;
  #define ROT() do{sl_prev=sl_cur;sl_cur=sl_next;sl_next=(sl_next==(NSLOT-1)*SLOTB)?0:sl_next+SLOTB;}while(0)
  DMA_K(2,2*SLOTB);
  WAIT_BAR(3);
  qkt(pA0,pA1,Kbase,qr,negm,r32,hi);asm volatile("s_nop 15\n\ts_nop 7":"+v"(pA0),"+v"(pA1));BIAS(pA0,pA1,0);CMASK(pA0,pA1,0);
  START(pA0,pA1);
  _Pragma("unroll") for(int r=0;r<16;++r)pA1[r]=__builtin_amdgcn_exp2f(pA1[r]);
  WAIT_BAR(0);
  DMA_K(3,0);DMA_V(1,SLOTB);
  ROT();
  kload8(kf,kp0+sl_cur);
  WAIT_BAR(2);
  s16x4 vlo[8],vhi[8]; u32x4 pw0,pw1,pw2,pw3;
  #define PKW(P,B) cvtpk_s(P[B],P[B+1])
  #define PAF(k) __builtin_bit_cast(bf16x8,pw##k)
  #define VFR(i) (bf16x8){vlo[i][0],vlo[i][1],vlo[i][2],vlo[i][3],vhi[i][0],vhi[i][1],vhi[i][2],vhi[i][3]}
  #define PIN(x) asm volatile("":"+v"(x))
  #define MX3(a,b,c) __builtin_fmaxf(__builtin_fmaxf((a),(b)),(c))
  #define GAPA(MF,A0,A1,A2,A3,W0,W1,PW) do{ MF; sacc+=A0; sacc+=A1; sacc+=A2; sacc+=A3; PIN(sacc); W0; W1; PIN(PW); SBAR(); }while(0)
  #define EX(v) __builtin_amdgcn_exp2f(v)
  #define GAPB(MF,X,B) do{ MF; X[B]=EX(X[B]); X[B+1]=EX(X[B+1]); X[B+2]=EX(X[B+2]); X[B+3]=EX(X[B+3]); PIN(X); SBAR(); }while(0)
  #define VRD(i) do{ vlo[i]=vtr(vp_+(((i)>>2)*4096+((i)&3)*1024)); vhi[i]=vtr(vp_+(((i)>>2)*4096+((i)&3)*1024+512)); }while(0)
  #define KRD(G,j) do{ if(G){ kload2(kf,kp0+sl_next,j); SBAR(); } }while(0)
  #define STEP(C0,C1,P0,P1,t,GK,GV,GL) do{ SBAR(); \
    const lds_cptr vp_=vp0+sl_prev; \
    VRD(0); SBAR(); float sacc=(P0[0]+P0[1]); \
    GAPA(C0=__builtin_amdgcn_mfma_f32_32x32x16_bf16(kf[0],qr[0],negm,0,0,0), P0[2],P0[3],P0[4],P0[5],     pw0[0]=PKW(P0,0), pw0[1]=PKW(P0,2), pw0); \
    VRD(4); SBAR(); GAPA(C1=__builtin_amdgcn_mfma_f32_32x32x16_bf16(kf[1],qr[0],negm,0,0,0), P0[6],P0[7],P0[8],P0[9],     pw0[2]=PKW(P0,4), pw0[3]=PKW(P0,6), pw0); \
    VRD(1); SBAR(); GAPA(C0=__builtin_amdgcn_mfma_f32_32x32x16_bf16(kf[2],qr[1],C0,0,0,0),   P0[10],P0[11],P0[12],P0[13], pw1[0]=PKW(P0,8), pw1[1]=PKW(P0,10), pw1); \
    VRD(5); SBAR(); GAPA(C1=__builtin_amdgcn_mfma_f32_32x32x16_bf16(kf[3],qr[1],C1,0,0,0),   P0[14],P0[15],P1[0],P1[1],   pw1[2]=PKW(P0,12),pw1[3]=PKW(P0,14), pw1); \
    VRD(2); SBAR(); GAPA(C0=__builtin_amdgcn_mfma_f32_32x32x16_bf16(kf[4],qr[2],C0,0,0,0),   P1[2],P1[3],P1[4],P1[5],     pw2[0]=PKW(P1,0), pw2[1]=PKW(P1,2), pw2); \
    VRD(6); SBAR(); GAPA(C1=__builtin_amdgcn_mfma_f32_32x32x16_bf16(kf[5],qr[2],C1,0,0,0),   P1[6],P1[7],P1[8],P1[9],     pw2[2]=PKW(P1,4), pw2[3]=PKW(P1,6), pw2); \
    VRD(3); SBAR(); GAPA(C0=__builtin_amdgcn_mfma_f32_32x32x16_bf16(kf[6],qr[3],C0,0,0,0),   P1[10],P1[11],P1[12],P1[13], pw3[0]=PKW(P1,8), pw3[1]=PKW(P1,10), pw3); \
    VRD(7); SBAR(); GAPA(C1=__builtin_amdgcn_mfma_f32_32x32x16_bf16(kf[7],qr[3],C1,0,0,0),   P1[14],P1[15],0.f,0.f,       pw3[2]=PKW(P1,12),pw3[3]=PKW(P1,14), pw3); \
    l_reg+=sacc; \
    if(GK){DMA_K((t)+3,sl_cur);} if(GV){DMA_V((t)+1,sl_next);} \
    BIAS(C0,C1,t); CMASK(C0,C1,t); \
    { float a=MX3(C0[0],C0[1],C1[0]),b=MX3(C0[2],C0[3],C1[1]); a=MX3(a,C1[2],C1[3]); \
      _Pragma("unroll") for(int r=4;r<16;r+=4){a=MX3(a,C0[r],C0[r+1]);b=MX3(b,C0[r+2],C0[r+3]);a=MX3(a,C1[r],C1[r+1]);b=MX3(b,C1[r+2],C1[r+3]);} \
      float rm=__builtin_fmaxf(a,b); { auto rr=__builtin_amdgcn_permlane32_swap(__float_as_uint(rm),__float_as_uint(rm),false,false); rm=__builtin_fmaxf(__uint_as_float(rr[0]),__uint_as_float(rr[1])); } \
      resc=false; \
      if(__builtin_expect(__any(rm>(float)THRL),0)){ const float dl=__builtin_fmaxf(rm,0.f); mhat+=dl; \
        _Pragma("unroll") for(int r=0;r<16;++r){C0[r]-=dl;C1[r]-=dl;} \
        const float f=__builtin_amdgcn_exp2f(-dl); l_reg*=f; if(hi==0)wsf[r32]=f; resc=true; } } \
    SBAR(); \
    GAPB(o[0]=__builtin_amdgcn_mfma_f32_32x32x16_bf16(PAF(0),VFR(0),o[0],0,0,0), C0,0); \
    GAPB(o[1]=__builtin_amdgcn_mfma_f32_32x32x16_bf16(PAF(0),VFR(4),o[1],0,0,0), C0,4); \
    KRD(GL,0); GAPB(o[0]=__builtin_amdgcn_mfma_f32_32x32x16_bf16(PAF(1),VFR(1),o[0],0,0,0), C0,8); \
    KRD(GL,1); GAPB(o[1]=__builtin_amdgcn_mfma_f32_32x32x16_bf16(PAF(1),VFR(5),o[1],0,0,0), C0,12); \
    KRD(GL,2); GAPB(o[0]=__builtin_amdgcn_mfma_f32_32x32x16_bf16(PAF(2),VFR(2),o[0],0,0,0), C1,0); \
    KRD(GL,3); GAPB(o[1]=__builtin_amdgcn_mfma_f32_32x32x16_bf16(PAF(2),VFR(6),o[1],0,0,0), C1,4); \
    GAPB(o[0]=__builtin_amdgcn_mfma_f32_32x32x16_bf16(PAF(3),VFR(3),o[0],0,0,0), C1,8); \
    GAPB(o[1]=__builtin_amdgcn_mfma_f32_32x32x16_bf16(PAF(3),VFR(7),o[1],0,0,0), C1,12); \
    }while(0)
  int t=1;
  #undef CMASK
  #define CMASK(P0,P1,t) do{}while(0)
  for(;t+5<NT;t+=2){
    STEP(pB0,pB1,pA0,pA1,t,true,true,true);     WAIT_BAR(2); RESC(); ROT();
    STEP(pA0,pA1,pB0,pB1,t+1,true,true,true);   WAIT_BAR(2); RESC(); ROT();
  }
  #undef CMASK
  #define CMASK(P0,P1,t) do{int jb_=(t)-(NT-4); if(jb_>=0)cmask(P0,P1,jb_,qrel,hi);}while(0)
  #define ENDW(tt) do{ if((tt)+3<NT){WAIT_BAR(2);} else if((tt)+2<NT){WAIT_BAR(1);} else {WAIT_BAR(0);} }while(0)
  for(;t+1<NT;t+=2){
    STEP(pB0,pB1,pA0,pA1,t,(t+3<NT),(t+1<NT),(t+1<NT));       ENDW(t);   RESC(); ROT();
    STEP(pA0,pA1,pB0,pB1,t+1,(t+4<NT),(t+2<NT),(t+2<NT));     ENDW(t+1); RESC(); ROT();
  }
  STEP(pB0,pB1,pA0,pA1,NT-1,false,false,false); RESC();
  { float sacc=pB0[0]+pB0[1]; _Pragma("unroll") for(int r=2;r<16;++r)sacc+=pB0[r]; _Pragma("unroll") for(int r=0;r<16;++r)sacc+=pB1[r]; l_reg+=sacc;
    pw0=(u32x4){PKW(pB0,0),PKW(pB0,2),PKW(pB0,4),PKW(pB0,6)};pw1=(u32x4){PKW(pB0,8),PKW(pB0,10),PKW(pB0,12),PKW(pB0,14)};pw2=(u32x4){PKW(pB1,0),PKW(pB1,2),PKW(pB1,4),PKW(pB1,6)};pw3=(u32x4){PKW(pB1,8),PKW(pB1,10),PKW(pB1,12),PKW(pB1,14)};
    SBAR(); pv(o,vb0+sl_cur,PAF(0),PAF(1),PAF(2),PAF(3)); }
  #undef PKW
  #undef PAF
  #undef VFR
  #undef PIN
  #undef MX3
  #undef GAPA
  #undef GAPB
  #undef EX
  #undef VRD
  #undef KRD
  #undef STEP
  #undef ENDW
  {auto rr=__builtin_amdgcn_permlane32_swap(__float_as_uint(l_reg),__float_as_uint(l_reg),false,false);l_reg=__uint_as_float(rr[0])+__uint_as_float(rr[1]);}
  if(hi==0)wsf[32+r32]=l_reg;asm volatile("s_waitcnt lgkmcnt(0)":::"memory");
  float rli[16];
  #pragma unroll
  for(int r=0;r<16;++r)rli[r]=__builtin_amdgcn_rcpf(wsf[32+crow(r,hi)]);
  bf16*Ow=O+(rowbase+q0+wid*QBLK)*DM+h*D;
  { bf16*stg=(bf16*)(shm+LDS_OST)+wid*2048;
    #pragma unroll
    for(int r=0;r<16;++r){const int orow=crow(r,hi);
      #pragma unroll
      for(int d0=0;d0<2;++d0)stg[orow*64+d0*32+r32]=__float2bfloat16(o[d0][r]*rli[r]);}
    asm volatile("s_waitcnt lgkmcnt(0)":::"memory");
    #pragma unroll
    for(int i=0;i<4;++i){const int row=i*8+(lane>>3),ch=lane&7; const u32x4 v=*(const u32x4*)(stg+row*64+ch*8); ATTN_STORE16(Ow+(long)row*DM+ch*8,v);} }
  asm volatile("s_waitcnt lgkmcnt(0)\n\ts_barrier":::"memory");
  #undef BIAS
  #undef DMA_K
  #undef DMA_V
  #undef CMASK
  #undef START
  #undef RESC
  #undef ROT
}
constexpr int ATTN_LDS_BYTES=LDS_BYTES;
#undef SBAR
#undef WAIT_BAR
}
constexpr size_t MiB = 1u << 20;
constexpr size_t ACT = (size_t)MT * DMODEL * 2;
constexpr size_t WS_CTL = 0;
constexpr size_t WS_MOD = 1 * MiB, WS_MODF = 3 * MiB;
constexpr size_t WS_W13A = 4 * MiB, WS_W2A = 16 * MiB, WS_W13B = 22 * MiB, WS_W2B = 34 * MiB, WS_WIN = 40 * MiB, WS_WR = 56 * MiB, WS_WA = 58 * MiB, WS_WO = 60 * MiB, WS_RGW = 62 * MiB;
constexpr size_t WS_HN = 64 * MiB, WS_XR = WS_HN + ACT, WS_GR = WS_XR + ACT, WS_Q = WS_GR + ACT, WS_K = WS_Q + ACT, WS_V = WS_K + ACT, WS_END = WS_V + ACT;
constexpr size_t WS_G = WS_XR;
static_assert(WS_G + (size_t)MT * DFF * 2 <= WS_K && WS_END + 2 * (size_t)MT * DMODEL <= 1024 * MiB, "ws map");
constexpr int WIN_ROWS = 7424;
constexpr size_t O_Y = 0, O_KP = 67371008, O_VP = 134479872, O_LFP = 201588736, O_CVP = 202637312, O_HP = 202735616, O_KS = 202768384, O_VS = 203030528, O_LFS = 203292672, O_CVS = 203296768, O_HS = 203345920;
constexpr int RING_BYTES = 131072, LDS_BYTES = 147456;
constexpr int NWAVES = 8, NPHASE = 15;

#define LAS __attribute__((address_space(3)))
typedef unsigned short bf16;
typedef unsigned v4u __attribute__((ext_vector_type(4)));
typedef unsigned v2u __attribute__((ext_vector_type(2)));
typedef float f32x4 __attribute__((ext_vector_type(4)));
typedef short bf16x8 __attribute__((ext_vector_type(8)));
#define LDS_WAIT() asm volatile("s_waitcnt lgkmcnt(0)" ::: "memory")
__device__ __forceinline__ unsigned f2bf(float f) { unsigned u = __builtin_bit_cast(unsigned, f); return (u + 0x7fffu + ((u >> 16) & 1u)) >> 16; }
__device__ __forceinline__ unsigned pk2(float lo, float hi) { return f2bf(lo) | (f2bf(hi) << 16); }
__device__ __forceinline__ float bf2f(unsigned short h) { return __uint_as_float((unsigned)h << 16); }
__device__ __forceinline__ float wave_sum(float v) {
#pragma unroll
    for (int o = 1; o < 64; o <<= 1) v += __shfl_xor(v, o);
    return v;
}

struct Params {
    const float *x_prompt, *x_sample, *cache_k, *cache_v, *cache_logf, *state_conv, *state_rglru, *c_prompt, *c_sample, *w_ada, *b_ada;
    const float *ffn1_norm, *ffn1_w1, *ffn1_w3, *ffn1_w2, *mix_norm, *w_in, *b_fgt, *conv_w, *conv_b, *rg_wa, *rg_ba, *rg_wx, *rg_bx, *rg_lam;
    const float *w_br_rnn, *w_br_att, *w_out, *ffn2_norm, *ffn2_w1, *ffn2_w3, *ffn2_w2, *final_norm, *w_ada_f, *b_ada_f;
    float* out; unsigned char* ws; int ph_lo, ph_hi;
};

template <int MODE> __device__ __forceinline__ void p0_transpose_item(const float* W, int ldw, int nblk, bf16* WT, int ldt, int row_off, LAS float* scr, int item, int lane) {
    const int kb = item / nblk, nb = item % nblk, k0 = 64 * kb, n0 = 32 * nb;
#pragma unroll 8
    for (int i = 0; i < 32; ++i) { const int kk = 2 * i + (lane >> 5); scr[kk * 33 + (lane & 31)] = W[(size_t)(k0 + kk) * ldw + n0 + (lane & 31)]; }
    LDS_WAIT(); asm volatile("" ::: "memory");
    const int c = lane & 7;
#pragma unroll
    for (int j = 0; j < 4; ++j) { const int n = (lane >> 3) + 8 * j; const LAS float* s = scr + (8 * c) * 33 + n;
        v4u o; o.x = pk2(s[0 * 33], s[1 * 33]); o.y = pk2(s[2 * 33], s[3 * 33]); o.z = pk2(s[4 * 33], s[5 * 33]); o.w = pk2(s[6 * 33], s[7 * 33]);
        const int nn = n0 + n; const int row = (MODE == 1) ? ((nn >> 7) * 256 + (nn & 127) + row_off) : (row_off + nn);
        *(v4u*)(WT + (size_t)row * ldt + k0 + 8 * c) = o; }
    LDS_WAIT(); asm volatile("" ::: "memory");
}

__device__ __forceinline__ void p0_ada_item(const Params& P, LAS unsigned char* lds, int cgi, int wave, int lane, int tid) {
    const bool fin = cgi >= 144; const int col = fin ? (cgi - 144) * 64 + lane : cgi * 64 + lane; const int ldw = fin ? 2 * DMODEL : NMOD * DMODEL;
    const float* W = (fin ? P.w_ada_f : P.w_ada) + col;
    LAS float* sw = (LAS float*)(lds + wave * 12288);
    float acc[NBT];
#pragma unroll
    for (int b = 0; b < NBT; ++b) acc[b] = 0.f;
    for (int p = 0; p < 2; ++p) {
        const int k0 = 128 * wave + 64 * p;
#pragma unroll
        for (int b = 0; b < NBT; ++b) { const float c = (b < NB_P) ? P.c_prompt[b * DMODEL + k0 + lane] : P.c_sample[(b - NB_P) * DMODEL + k0 + lane]; sw[b * 64 + lane] = c / (1.0f + __expf(-c)); }
        LDS_WAIT(); asm volatile("" ::: "memory");
#pragma unroll 4
        for (int k4 = 0; k4 < 16; ++k4) {
            const float w0 = W[(size_t)(k0 + 4 * k4 + 0) * ldw], w1 = W[(size_t)(k0 + 4 * k4 + 1) * ldw], w2 = W[(size_t)(k0 + 4 * k4 + 2) * ldw], w3 = W[(size_t)(k0 + 4 * k4 + 3) * ldw];
#pragma unroll
            for (int b = 0; b < NBT; ++b) { const f32x4 s = *(const LAS f32x4*)(sw + b * 64 + 4 * k4); acc[b] += (s[0] * w0 + s[1] * w1) + (s[2] * w2 + s[3] * w3); }
        }
        LDS_WAIT(); asm volatile("" ::: "memory");
    }
#pragma unroll
    for (int b = 0; b < NBT; ++b) sw[b * 64 + lane] = acc[b];
    __syncthreads();
    for (int i = 0; i < 6; ++i) { const int idx = tid + 512 * i, b = idx >> 6, ln = idx & 63; float s = 0.f;
#pragma unroll
        for (int w = 0; w < 8; ++w) s += *((const LAS float*)(lds + w * 12288) + b * 64 + ln);
        const int cc = fin ? (cgi - 144) * 64 + ln : cgi * 64 + ln;
        if (fin) ((float*)(P.ws + WS_MODF))[b * (2 * DMODEL) + cc] = s + P.b_ada_f[cc];
        else ((float*)(P.ws + WS_MOD))[b * (NMOD * DMODEL) + cc] = s + P.b_ada[cc]; }
    __syncthreads();
}

__device__ __forceinline__ void p0_ada(const Params& P, LAS unsigned char* lds, int wave, int lane, int tid) {
    const int G = gridDim.x;
    for (int cgi = blockIdx.x; cgi < 176; cgi += G) p0_ada_item(P, lds, cgi, wave, lane, tid);
}
__device__ __forceinline__ void p0_prologue(const Params& P, LAS unsigned char* lds, int wave, int lane, int tid) {
    const int G = gridDim.x;
    LAS float* scr = (LAS float*)(lds + wave * 16384);
    const int gw = blockIdx.x * NWAVES + wave, NGW = G * NWAVES;
    bf16* W13A = (bf16*)(P.ws + WS_W13A); bf16* W2A = (bf16*)(P.ws + WS_W2A); bf16* W13B = (bf16*)(P.ws + WS_W13B); bf16* W2B = (bf16*)(P.ws + WS_W2B);
    bf16* WIN = (bf16*)(P.ws + WS_WIN); bf16* WR = (bf16*)(P.ws + WS_WR); bf16* WA = (bf16*)(P.ws + WS_WA); bf16* WO = (bf16*)(P.ws + WS_WO); bf16* RGW = (bf16*)(P.ws + WS_RGW);
    constexpr int I_UP = 16 * 88, I_DN = 44 * 32, I_IN1 = 16 * 160, I_IN2 = 16 * 64, I_SQ = 16 * 32, I_RG = 32, I_FL = 128;
    constexpr int NITEMS = 4 * I_UP + 2 * I_DN + I_IN1 + I_IN2 + 3 * I_SQ + 2 * I_RG + I_FL;
    for (int it = gw; it < NITEMS; it += NGW) {
        int r = it;
        if (r < I_UP) { p0_transpose_item<1>(P.ffn1_w1, DFF, 88, W13A, DMODEL, 0, scr, r, lane); continue; } r -= I_UP;
        if (r < I_UP) { p0_transpose_item<1>(P.ffn1_w3, DFF, 88, W13A, DMODEL, 128, scr, r, lane); continue; } r -= I_UP;
        if (r < I_UP) { p0_transpose_item<1>(P.ffn2_w1, DFF, 88, W13B, DMODEL, 0, scr, r, lane); continue; } r -= I_UP;
        if (r < I_UP) { p0_transpose_item<1>(P.ffn2_w3, DFF, 88, W13B, DMODEL, 128, scr, r, lane); continue; } r -= I_UP;
        if (r < I_DN) { p0_transpose_item<0>(P.ffn1_w2, DMODEL, 32, W2A, DFF, 0, scr, r, lane); continue; } r -= I_DN;
        if (r < I_DN) { p0_transpose_item<0>(P.ffn2_w2, DMODEL, 32, W2B, DFF, 0, scr, r, lane); continue; } r -= I_DN;
        if (r < I_IN1) { p0_transpose_item<0>(P.w_in, INCOLS, 160, WIN, DMODEL, 0, scr, r, lane); continue; } r -= I_IN1;
        if (r < I_IN2) { p0_transpose_item<0>(P.w_in + 5136, INCOLS, 64, WIN, DMODEL, 5376, scr, r, lane); continue; } r -= I_IN2;
        if (r < I_SQ) { p0_transpose_item<0>(P.w_br_rnn, DMODEL, 32, WR, DMODEL, 0, scr, r, lane); continue; } r -= I_SQ;
        if (r < I_SQ) { p0_transpose_item<0>(P.w_br_att, DMODEL, 32, WA, DMODEL, 0, scr, r, lane); continue; } r -= I_SQ;
        if (r < I_SQ) { p0_transpose_item<0>(P.w_out, DMODEL, 32, WO, DMODEL, 0, scr, r, lane); continue; } r -= I_SQ;
        if (r < 2 * I_RG) { const int mat = r / I_RG, rr = r % I_RG, blk = rr >> 1, sub = rr & 1;
            p0_transpose_item<0>((mat ? P.rg_wx : P.rg_wa) + blk * 4096, 64, 2, RGW + mat * 65536 + blk * 4096, 64, 0, scr, sub, lane); continue; } r -= 2 * I_RG;
        {
#pragma unroll
            for (int h2 = 0; h2 < 2; ++h2) { const int j = 2 * r + h2; bf16* dst = WIN + (size_t)(5120 + j) * DMODEL + lane * 16;
                unsigned w[8];
#pragma unroll
                for (int q = 0; q < 8; ++q) { float a = 0.f, b = 0.f; if (j < 16) { a = P.w_in[(size_t)(lane * 16 + 2 * q) * INCOLS + 5120 + j]; b = P.w_in[(size_t)(lane * 16 + 2 * q + 1) * INCOLS + 5120 + j]; } w[q] = pk2(a, b); }
                *(v4u*)dst = (v4u){w[0], w[1], w[2], w[3]}; *(v4u*)(dst + 8) = (v4u){w[4], w[5], w[6], w[7]}; }
        }
    }
}

template <bool OUT_F32, bool IN_BF16> __device__ __forceinline__ void norm_phase(const float* srcP, const float* srcS, const bf16* srcB, const float* gvec, const float* modbase, int modstride, int jshift, int jscale,
                                                                   bf16* outb, float* outf, int wave, int lane) {
    const int gw = blockIdx.x * NWAVES + wave, NGW = gridDim.x * NWAVES;
    for (int grp = gw; grp < MT / 32; grp += NGW) {
        const int r0 = grp * 32; int bprev = -1; f32x4 gs[4], sh[4];
        for (int i = 0; i < 32; i += 4) {
            const int r = r0 + i, b = batch_of_row(r);
            if (b != bprev) { bprev = b;
#pragma unroll
                for (int j = 0; j < 4; ++j) { const int c = 4 * lane + 256 * j; const f32x4 g = *(const f32x4*)(gvec + c), sc = *(const f32x4*)(modbase + (size_t)b * modstride + jscale * DMODEL + c);
                    gs[j] = g * (sc + 1.0f); sh[j] = *(const f32x4*)(modbase + (size_t)b * modstride + jshift * DMODEL + c); } }
            f32x4 v[4][4]; float ss[4];
            if (IN_BF16) {
                v2u w[4][4];
#pragma unroll
                for (int q = 0; q < 4; ++q)
#pragma unroll
                    for (int j = 0; j < 4; ++j) w[q][j] = *(const v2u*)(srcB + (size_t)(r + q) * DMODEL + 4 * lane + 256 * j);
#pragma unroll
                for (int q = 0; q < 4; ++q)
#pragma unroll
                    for (int j = 0; j < 4; ++j) v[q][j] = (f32x4){__uint_as_float(w[q][j].x << 16), __uint_as_float(w[q][j].x & 0xffff0000u), __uint_as_float(w[q][j].y << 16), __uint_as_float(w[q][j].y & 0xffff0000u)};
            } else {
                const float* x0 = (r < MP ? srcP + (size_t)r * DMODEL : srcS + (size_t)(r - MP) * DMODEL) + 4 * lane;
#pragma unroll
                for (int q = 0; q < 4; ++q)
#pragma unroll
                    for (int j = 0; j < 4; ++j) v[q][j] = *(const f32x4*)(x0 + (size_t)q * DMODEL + 256 * j);
            }
#pragma unroll
            for (int q = 0; q < 4; ++q) { float s = 0.f;
#pragma unroll
                for (int j = 0; j < 4; ++j) s += (v[q][j][0] * v[q][j][0] + v[q][j][1] * v[q][j][1]) + (v[q][j][2] * v[q][j][2] + v[q][j][3] * v[q][j][3]);
                ss[q] = 1.0f / sqrtf(wave_sum(s) * (1.0f / DMODEL) + 1e-6f); }
#pragma unroll
            for (int q = 0; q < 4; ++q)
#pragma unroll
                for (int j = 0; j < 4; ++j) { const f32x4 a = v[q][j] * ss[q] * gs[j] + sh[j];
                    if (OUT_F32) *(f32x4*)(outf + (size_t)(r + q) * DMODEL + 4 * lane + 256 * j) = a;
                    else *(v2u*)(outb + (size_t)(r + q) * DMODEL + 4 * lane + 256 * j) = (v2u){pk2(a[0], a[1]), pk2(a[2], a[3])}; }
        }
    }
}
#define XB_TMO      128
#define XB_XCNT(j)  (256  + 64 * (j))
#define XB_XSUB(j)  (1280 + 64 * (j))
#define XB_XGEN(j)  (2304 + 64 * (j))
#define XB_TOP      3328
#define XB_TOPGEN   3392
#define XCD_BAR_WORDS 3456
#define XB_SPIN_CAP (1u << 18)

__device__ __forceinline__ unsigned xb_ld(unsigned* p)              { return __hip_atomic_load(p, __ATOMIC_RELAXED, __HIP_MEMORY_SCOPE_AGENT); }
__device__ __forceinline__ unsigned xb_add(unsigned* p, unsigned v) { return __hip_atomic_fetch_add(p, v, __ATOMIC_RELAXED, __HIP_MEMORY_SCOPE_AGENT); }
__device__ __forceinline__ unsigned xb_xcc_id() { return (unsigned)__builtin_amdgcn_s_getreg((3 << 11) | 20) & 0xFu; }
#define XB_SPIN(cond, bar) do { unsigned _sp = 0; while (cond) { __builtin_amdgcn_s_sleep(1); \
    if ((++_sp & 255u) == 0u) { if (xb_ld(&(bar)[XB_TMO])) break; if (_sp > XB_SPIN_CAP) { atomicAdd(&(bar)[XB_TMO], 1u); break; } } } } while (0)

struct XcdBarrier {
    unsigned* bar; unsigned x;
    volatile LAS unsigned* st;
};

__device__ __forceinline__ XcdBarrier xcd_barrier_post(unsigned* bar, volatile LAS unsigned* st, int tid) {
    XcdBarrier b; b.bar = bar; b.x = xb_xcc_id(); b.st = st;
    if (tid == 0) (void)xb_add(&bar[XB_XCNT(b.x)], 1u);
    return b;
}
__device__ __forceinline__ void xcd_barrier_complete(unsigned* bar, unsigned x, unsigned& nloc, unsigned& nx) {
    const unsigned G = gridDim.x * gridDim.y * gridDim.z;
    unsigned sum, cnt, mine, sp = 0u;
    for (;;) {
        sum = 0u; cnt = 0u; mine = 0u;
#pragma unroll
        for (unsigned j = 0; j < 16; ++j) { const unsigned c = xb_ld(&bar[XB_XCNT(j)]); sum += c; cnt += (c > 0u) ? 1u : 0u; mine = (j == x) ? c : mine; }
        if (sum == G) break;
        __builtin_amdgcn_s_sleep(1);
        if ((++sp & 255u) == 0u) { if (xb_ld(&bar[XB_TMO])) break; if (sp > XB_SPIN_CAP) { atomicAdd(&bar[XB_TMO], 1u); break; } }
    }
    nloc = mine > 0u ? mine : 1u; nx = cnt > 0u ? cnt : 1u;
}

__device__ __forceinline__ void xcd_barrier(const XcdBarrier& b, int tid) {
    asm volatile("s_waitcnt vmcnt(0)" ::: "memory");
    __syncthreads();
    if (tid == 0) {
        unsigned* bar = b.bar;
        __builtin_amdgcn_s_waitcnt(0);
        unsigned nloc = b.st[0], nx = b.st[1];
        if (nloc == 0u) { xcd_barrier_complete(bar, b.x, nloc, nx); b.st[0] = nloc; b.st[1] = nx; }
        const unsigned old = xb_add(&bar[XB_XSUB(b.x)], 1u);
        const unsigned gen = old / nloc;
        if (old + 1u == (gen + 1u) * nloc) {
            __builtin_amdgcn_fence(__ATOMIC_RELEASE, "agent");
            asm volatile("s_waitcnt vmcnt(0)" ::: "memory");
            const unsigned og = xb_add(&bar[XB_TOP], 1u);
            const unsigned tg = og / nx;
            if (og + 1u == (tg + 1u) * nx) xb_add(&bar[XB_TOPGEN], 1u);
            else XB_SPIN(xb_ld(&bar[XB_TOPGEN]) == tg, bar);
            __builtin_amdgcn_fence(__ATOMIC_ACQUIRE, "agent");
            xb_add(&bar[XB_XGEN(b.x)], 1u);
            asm volatile("s_waitcnt vmcnt(0)" ::: "memory");
        } else {
            XB_SPIN(xb_ld(&bar[XB_XGEN(b.x)]) == gen, bar);
            __builtin_amdgcn_fence(__ATOMIC_ACQUIRE, "agent");
            asm volatile("s_waitcnt vmcnt(0)" ::: "memory");
        }
    }
    __syncthreads();
}
namespace sg {
using pg8::bf16_t; using pg8::f32x4; using pg8::u32x4; using pg8::u32x2; using pg8::cvt_pk_bf16; using pg8::sigmoid_f; using pg8::silu_f; using pg8::gelu_tanh_f; using pg8::bf_lo; using pg8::bf_hi; using pg8::gate4; using pg8::ungate4;
__device__ __forceinline__ u32x2 pack4(f32x4 v) { u32x2 w; w.x = cvt_pk_bf16(v[0], v[1]); w.y = cvt_pk_bf16(v[2], v[3]); return w; }
struct SSwiglu { bf16_t* G; __device__ __forceinline__ void operator()(int row, int col, f32x4 a, f32x4 b) const { f32x4 v;
#pragma unroll
        for (int i = 0; i < 4; ++i) v[i] = silu_f(a[i]) * b[i];
        *(u32x2*)(G + (size_t)row * DFF + col) = pack4(v); } };
template <bool WF32> struct SResid { const float* baseS; float* out; const float* mod; int jmod; float mult; bf16_t* XB;
    __device__ __forceinline__ void operator()(int row, int col, f32x4 a, f32x4) const { const int b = batch_of_row(row);
        const f32x4 bs = *(const f32x4*)(baseS + (size_t)(row - MP) * DMODEL + col), mv = *(const f32x4*)(mod + (size_t)b * (NMOD * DMODEL) + jmod * DMODEL + col);
        const f32x4 o = bs + (mv + 1.0f) * mult * a;
        if (WF32) *(f32x4*)(out + (size_t)row * DMODEL + col) = o;
        *(u32x2*)(XB + (size_t)row * DMODEL + col) = pack4(o); } };
struct SIn { bf16_t *XR, *GR, *Q, *K, *V; float* dout; const float* bfgt; float qscale;
    __device__ __forceinline__ void operator()(int row, int col, f32x4 v, f32x4) const { const int rs = row - MP; const bool isfl = col >= 5120;
        const int reg = isfl ? 5 : (col >> 10), c = col & 1023; float* fdst = nullptr; f32x4 fv = v;
        if (isfl) { const f32x4 x = v + *(const f32x4*)(bfgt + (col - 5120));
#pragma unroll
            for (int i = 0; i < 4; ++i) fv[i] = fminf(x[i], 0.f) - log1pf(__expf(-fabsf(x[i])));
            fdst = dout + (size_t)203292672 + (size_t)rs * NHEAD + (col - 5120); }
        else if (reg == 3) fdst = dout + (size_t)202768384 + (size_t)rs * DMODEL + c;
        else if (reg == 4) fdst = dout + (size_t)203030528 + (size_t)rs * DMODEL + c;
        else if (reg == 0) { const int t = (rs & 15) - 13; if (t >= 0) fdst = dout + (size_t)203296768 + ((size_t)(rs >> 4) * 3 + t) * DMODEL + c; }
        if (fdst) *(f32x4*)fdst = fv;
        if (reg == 1) {
#pragma unroll
            for (int i = 0; i < 4; ++i) v[i] = gelu_tanh_f(v[i]); }
        if (reg == 2) v = v * qscale;
        bf16_t* dst = XR + (size_t)reg * ((size_t)MT * DMODEL);
        if (!isfl) *(u32x2*)(dst + (size_t)row * DMODEL + c) = pack4(v); } };
struct SGate { unsigned char *GA8, *GB8; __device__ __forceinline__ void operator()(int row, int col, f32x4 v, f32x4) const {
        *(unsigned*)((col < DMODEL ? GA8 : GB8) + (size_t)row * DMODEL + (col & 1023)) = gate4(v); } };
template <bool ADD> struct SZ { const unsigned char* GATE; bf16_t* Z; __device__ __forceinline__ void operator()(int row, int col, f32x4 v, f32x4) const { const size_t off = (size_t)row * DMODEL + col;
        v = v * ungate4(*(const unsigned*)(GATE + off));
        if (ADD) { const u32x2 z = *(const u32x2*)(Z + off); v[0] += bf_lo(z.x); v[1] += bf_hi(z.x); v[2] += bf_lo(z.y); v[3] += bf_hi(z.y); }
        *(u32x2*)(Z + off) = pack4(v); } };

template <bool DUAL, class SEpi> __device__ __forceinline__ void sample_gemm(const bf16_t* A, const bf16_t* Bt, int ncb, int K, const SEpi& E, int gw, int NGW, int lane) {
    const int li = lane & 15, g = lane >> 4, nsteps = K >> 5;
    for (int it = gw; it < 16 * ncb; it += NGW) {
        const int rb = it & 15, cb = it >> 4, c16 = 16 * cb;
        const bf16_t* ap = A + (size_t)(MP + 16 * rb + li) * K + 8 * g;
        const int brow = DUAL ? ((c16 >> 7) * 256 + (c16 & 127) + li) : (c16 + li);
        const bf16_t* bp = Bt + (size_t)brow * K + 8 * g; const bf16_t* bp3 = bp + (size_t)128 * K;
        f32x4 acc0 = (f32x4){0.f, 0.f, 0.f, 0.f}, acc1 = acc0;
#pragma unroll 8
        for (int s = 0; s < nsteps; ++s) { const pg8::bf16x8 a = *(const pg8::bf16x8*)(ap + 32 * s), b = *(const pg8::bf16x8*)(bp + 32 * s);
            acc0 = __builtin_amdgcn_mfma_f32_16x16x32_bf16(b, a, acc0, 0, 0, 0);
            if (DUAL) { const pg8::bf16x8 b3 = *(const pg8::bf16x8*)(bp3 + 32 * s); acc1 = __builtin_amdgcn_mfma_f32_16x16x32_bf16(b3, a, acc1, 0, 0, 0); } }
        E(MP + 16 * rb + li, c16 + 4 * g, acc0, acc1);
    }
}
}
typedef float f32x4m __attribute__((ext_vector_type(4)));
constexpr float LOG2E = 1.4426950408889634f;

__device__ __forceinline__ void forget_table(const float* lf, int stride, const float* tail, int ntail, LAS float* nf, LAS float* wtot, int tid, int lane, int wave) {
    float v0 = lf[(size_t)(4 * tid + 0) * stride], v1 = lf[(size_t)(4 * tid + 1) * stride], v2 = lf[(size_t)(4 * tid + 2) * stride], v3 = lf[(size_t)(4 * tid + 3) * stride];
    v1 += v0; v2 += v1; v3 += v2;
    float s = v3; int ln = lane; asm volatile("" : "+v"(ln));
#pragma unroll
    for (int o = 1; o < 64; o <<= 1) { const float t = __uint_as_float(__builtin_amdgcn_ds_bpermute(((ln - o) & 63) << 2, __float_as_uint(s))); if (ln >= o) s += t; }
    if (lane == 63) wtot[wave] = s;
    __syncthreads();
    float base = s - v3;
    for (int w = 0; w < wave; ++w) base += wtot[w];
    *(LAS f32x4m*)(nf + 4 * tid) = (f32x4m){-LOG2E * (base + v0), -LOG2E * (base + v1), -LOG2E * (base + v2), -LOG2E * (base + v3)};
    if (ntail > 0 && tid == 511) { float c = base + v3; for (int i = 0; i < ntail; ++i) { c += tail[i * 16]; nf[2048 + i] = -LOG2E * c; } }
    __syncthreads();
}

__device__ __forceinline__ void sattn_unit(const Params& P, int b, int h, LAS unsigned char* lds, int tid, int lane, int wave) {
    LAS float* nf = (LAS float*)lds;
    LAS float* wtot = (LAS float*)(lds + 8448);
    LAS float* PO = (LAS float*)(lds + 16384);
    LAS float* PM = (LAS float*)(lds + 16384 + 32768);
    LAS float* PL = PM + 128;
    const float* lf_new = P.out + O_LFS + (size_t)b * TS * NHEAD + h;
    forget_table(P.cache_logf + (size_t)b * PAST * NHEAD + h, NHEAD, lf_new, TS, nf, wtot, tid, lane, wave);
    const int li = lane & 15, g = lane >> 4;
    const bf16* qrow = (const bf16*)(P.ws + WS_Q) + (size_t)(MP + b * TS + li) * DMODEL + h * 64;
    float qf[4][4];
#pragma unroll
    for (int c = 0; c < 4; ++c) { const v2u w = *(const v2u*)(qrow + 16 * c + 4 * g); qf[c][0] = __uint_as_float(w.x << 16); qf[c][1] = __uint_as_float(w.x & 0xffff0000u); qf[c][2] = __uint_as_float(w.y << 16); qf[c][3] = __uint_as_float(w.y & 0xffff0000u); }
    const float* ck = P.cache_k + ((size_t)b * PAST * NHEAD + h) * 64; const float* cv = P.cache_v + ((size_t)b * PAST * NHEAD + h) * 64;
    const float* nk = P.out + O_KS + ((size_t)b * TS * NHEAD + h) * 64; const float* nv = P.out + O_VS + ((size_t)b * TS * NHEAD + h) * 64;
    float m = -INFINITY, l = 0.f; f32x4m o[4];
#pragma unroll
    for (int j = 0; j < 4; ++j) o[j] = (f32x4m){0.f, 0.f, 0.f, 0.f};
    const int nblk = (wave == 0) ? 17 : 16;
    f32x4m kf[4], vf[4], kg[4], vg[4];
#define SA_LOAD(KD, VD, IB) do { const bool nn_ = ((IB) == 16); const int k1_ = 16 * (16 * wave + (IB)); \
        const float* kb_ = nn_ ? nk : ck + (size_t)k1_ * (NHEAD * 64); const float* vb_ = nn_ ? nv : cv + (size_t)k1_ * (NHEAD * 64); \
        _Pragma("unroll") for (int c = 0; c < 4; ++c) KD[c] = *(const f32x4m*)(kb_ + (size_t)li * (NHEAD * 64) + 16 * c + 4 * g); \
        _Pragma("unroll") for (int i = 0; i < 4; ++i) VD[i] = *(const f32x4m*)(vb_ + (size_t)(4 * g + i) * (NHEAD * 64) + 4 * li); } while (0)
    SA_LOAD(kf, vf, 0); SA_LOAD(kg, vg, 1);
    for (int ib = 0; ib < nblk; ++ib) {
        const bool isnew = (ib == 16); const int key0 = isnew ? PAST : 16 * (16 * wave + ib);
        f32x4m kc[4], vc[4];
#pragma unroll
        for (int c = 0; c < 4; ++c) { kc[c] = kf[c]; vc[c] = vf[c]; kf[c] = kg[c]; vf[c] = vg[c]; }
        if (ib + 2 < nblk) SA_LOAD(kg, vg, ib + 2);
        f32x4m s = (f32x4m){0.f, 0.f, 0.f, 0.f};
#pragma unroll
        for (int c = 0; c < 4; ++c)
#pragma unroll
            for (int j = 0; j < 4; ++j) s = __builtin_amdgcn_mfma_f32_16x16x4f32(kc[c][j], qf[c][j], s, 0, 0, 0);
        const f32x4m nb = *(const LAS f32x4m*)(nf + key0 + 4 * g);
        s = s + nb;
        if (isnew) {
#pragma unroll
            for (int r = 0; r < 4; ++r) if (4 * g + r > li) s[r] = -INFINITY; }
        float bm = fmaxf(fmaxf(s[0], s[1]), fmaxf(s[2], s[3]));
        bm = fmaxf(bm, __shfl_xor(bm, 16)); bm = fmaxf(bm, __shfl_xor(bm, 32));
        const float mn = fmaxf(m, bm), alpha = __builtin_amdgcn_exp2f(m - mn);
        float p[4];
#pragma unroll
        for (int r = 0; r < 4; ++r) p[r] = __builtin_amdgcn_exp2f(s[r] - mn);
        l = l * alpha + ((p[0] + p[1]) + (p[2] + p[3])); m = mn;
#pragma unroll
        for (int r = 0; r < 4; ++r) { const float ar = __shfl(alpha, 4 * g + r);
#pragma unroll
            for (int j = 0; j < 4; ++j) o[j][r] *= ar; }
#pragma unroll
        for (int i = 0; i < 4; ++i)
#pragma unroll
            for (int j = 0; j < 4; ++j) o[j] = __builtin_amdgcn_mfma_f32_16x16x4f32(p[i], vc[i][j], o[j], 0, 0, 0);
    }
#undef SA_LOAD
    l += __shfl_xor(l, 16); l += __shfl_xor(l, 32);
    if (g == 0) { PM[wave * 16 + li] = m; PL[wave * 16 + li] = l; }
#pragma unroll
    for (int r = 0; r < 4; ++r) *(LAS f32x4m*)(PO + (wave * 16 + 4 * g + r) * 64 + 4 * li) = (f32x4m){o[0][r], o[1][r], o[2][r], o[3][r]};
    __syncthreads();
    {   const int q = tid >> 5, d = 2 * (tid & 31); float M = -INFINITY;
#pragma unroll
        for (int w = 0; w < 8; ++w) M = fmaxf(M, PM[w * 16 + q]);
        float den = 0.f, n0 = 0.f, n1 = 0.f;
#pragma unroll
        for (int w = 0; w < 8; ++w) { const float f = __builtin_amdgcn_exp2f(PM[w * 16 + q] - M); den += f * PL[w * 16 + q]; n0 += f * PO[(w * 16 + q) * 64 + d]; n1 += f * PO[(w * 16 + q) * 64 + d + 1]; }
        const float inv = 1.0f / den;
        *(unsigned*)((bf16*)(P.ws + WS_Q) + (size_t)(MP + b * TS + q) * DMODEL + h * 64 + d) = pk2(n0 * inv, n1 * inv); }
    __syncthreads();
}

__device__ __forceinline__ void rglru_item(const Params& P, int row_base, int T, int n, const float* tail0, const float* h0, float* hlast, LAS unsigned char* lds, int tid, int lane, int wave) {
    LAS float* XS = (LAS float*)lds;
    LAS float* XC = (LAS float*)(lds + 33792);
    LAS float* AA = (LAS float*)(lds + 66560);
    LAS bf16* XCB = (LAS bf16*)(lds + 99328);
    LAS float* AH = (LAS float*)(lds + 117760);
    LAS bf16* GRS = (LAS bf16*)(lds + 121856);
    const int c0 = 64 * n, li = lane & 15, g = lane >> 4;
    const bf16* XR = (const bf16*)(P.ws + WS_XR); bf16* GR = (bf16*)(P.ws + WS_GR);
    const int cc = tid & 63, tr = tid >> 6;
    const float cw0 = P.conv_w[0 * DMODEL + c0 + cc], cw1 = P.conv_w[1 * DMODEL + c0 + cc], cw2 = P.conv_w[2 * DMODEL + c0 + cc], cw3 = P.conv_w[3 * DMODEL + c0 + cc], cbv = P.conv_b[c0 + cc];
    float gba[4], gbx[4], gsp[4];
#pragma unroll
    for (int ct = 0; ct < 4; ++ct) { const int c = c0 + 16 * ct + li; gba[ct] = P.rg_ba[c]; gbx[ct] = P.rg_bx[c]; const float lam = P.rg_lam[c];
        const float sp = (lam < -15.f) ? -lam : log1pf(__expf(-lam)); gsp[ct] = -8.0f * sp; }
    bf16x8 wfa[4][2], wfx[4][2];
    { const bf16* RGW = (const bf16*)(P.ws + WS_RGW) + n * 4096;
#pragma unroll
      for (int ct = 0; ct < 4; ++ct)
#pragma unroll
        for (int s = 0; s < 2; ++s) { wfa[ct][s] = *(const bf16x8*)(RGW + (16 * ct + li) * 64 + 32 * s + 8 * g); wfx[ct][s] = *(const bf16x8*)(RGW + 65536 + (16 * ct + li) * 64 + 32 * s + 8 * g); } }
    float hc = h0 ? h0[c0 + lane] : 0.f;
    const int nchunk = (T + 127) / 128;
    const int prow0 = tid >> 3, pc8 = (tid & 7) * 8;
    v4u xpre[2], gpre[2];
#pragma unroll
    for (int i = 0; i < 2; ++i) { const int row = prow0 + 64 * i; xpre[i] = (v4u){0u, 0u, 0u, 0u}; gpre[i] = xpre[i];
        if (row < T) { const size_t o = (size_t)(row_base + row) * DMODEL + c0 + pc8; xpre[i] = *(const v4u*)(XR + o); gpre[i] = *(const v4u*)(GR + o); } }
    for (int ch = 0; ch < nchunk; ++ch) {
        const int t0 = ch * 128, nvalid = (T - t0) < 128 ? (T - t0) : 128;
        float tv = 0.f;
        if (tid < 192) { if (ch == 0) tv = tail0 ? tail0[(size_t)(tid >> 6) * DMODEL + c0 + (tid & 63)] : 0.f; else tv = XS[(128 + (tid >> 6)) * 64 + (tid & 63)]; }
        __syncthreads();
        if (tid < 192) XS[(tid >> 6) * 64 + (tid & 63)] = tv;
#pragma unroll
        for (int i = 0; i < 2; ++i) { const int row = prow0 + 64 * i; const v4u w = xpre[i];
            LAS float* d = XS + (3 + row) * 64 + pc8;
            *(LAS f32x4m*)d = (f32x4m){__uint_as_float(w.x << 16), __uint_as_float(w.x & 0xffff0000u), __uint_as_float(w.y << 16), __uint_as_float(w.y & 0xffff0000u)};
            *(LAS f32x4m*)(d + 4) = (f32x4m){__uint_as_float(w.z << 16), __uint_as_float(w.z & 0xffff0000u), __uint_as_float(w.w << 16), __uint_as_float(w.w & 0xffff0000u)};
            *(LAS v4u*)(GRS + row * 64 + pc8) = gpre[i]; }
        if (ch + 1 < nchunk) {
#pragma unroll
            for (int i = 0; i < 2; ++i) { const int row = t0 + 128 + prow0 + 64 * i; xpre[i] = (v4u){0u, 0u, 0u, 0u}; gpre[i] = xpre[i];
                if (row < T) { const size_t o = (size_t)(row_base + row) * DMODEL + c0 + pc8; xpre[i] = *(const v4u*)(XR + o); gpre[i] = *(const v4u*)(GR + o); } } }
        __syncthreads();
#pragma unroll 4
        for (int i = 0; i < 16; ++i) { const int t = 16 * tr + i;
            const float y = cbv + (cw0 * XS[t * 64 + cc] + cw1 * XS[(t + 1) * 64 + cc]) + (cw2 * XS[(t + 2) * 64 + cc] + cw3 * XS[(t + 3) * 64 + cc]);
            XC[t * 64 + cc] = y; XCB[t * 72 + cc] = (bf16)f2bf(y); }
        { bf16x8 af[2];
#pragma unroll
          for (int s = 0; s < 2; ++s) af[s] = *(const LAS bf16x8*)(XCB + (16 * wave + li) * 72 + 32 * s + 8 * g);
#pragma unroll
          for (int ct = 0; ct < 4; ++ct) { f32x4m pa = (f32x4m){0.f, 0.f, 0.f, 0.f}, px = pa;
#pragma unroll
            for (int s = 0; s < 2; ++s) { pa = __builtin_amdgcn_mfma_f32_16x16x32_bf16(af[s], wfa[ct][s], pa, 0, 0, 0); px = __builtin_amdgcn_mfma_f32_16x16x32_bf16(af[s], wfx[ct][s], px, 0, 0, 0); }
#pragma unroll
            for (int r = 0; r < 4; ++r) { const int t = 16 * wave + 4 * g + r, c = 16 * ct + li;
                const float rr = pg8::sigmoid_f(pa[r] + gba[ct]), ii = pg8::sigmoid_f(px[r] + gbx[ct]);
                const float la = gsp[ct] * rr, a = __expf(la);
                const float om = (1.0f - a) * (1.0f + a);
                const float u = sqrtf(om) * ii * XC[t * 64 + c];
                AA[t * 64 + c] = a; XC[t * 64 + c] = u; } } }
        { float A = 1.f, H = 0.f;
#pragma unroll
          for (int tt = 0; tt < 16; ++tt) { const float a = AA[(16 * wave + tt) * 64 + lane], u = XC[(16 * wave + tt) * 64 + lane]; H = a * H + u; A *= a; }
          AH[(wave * 2 + 0) * 64 + lane] = A; AH[(wave * 2 + 1) * 64 + lane] = H; }
        __syncthreads();
        { const int nvw = nvalid >> 4; float hin = hc, hend = hc;
#pragma unroll
          for (int w = 0; w < 8; ++w) { const float A = AH[(w * 2) * 64 + lane], H = AH[(w * 2 + 1) * 64 + lane]; if (w < wave) hin = A * hin + H; if (w < nvw) hend = A * hend + H; }
          if (wave < nvw) { float h = hin;
#pragma unroll
            for (int tt = 0; tt < 16; ++tt) { const int t = 16 * wave + tt; const float a = AA[t * 64 + lane], u = XC[t * 64 + lane]; h = a * h + u;
                GRS[t * 64 + lane] = (bf16)f2bf(h * bf2f(GRS[t * 64 + lane])); } }
          if (wave < nvw) { const int row = 16 * wave + (lane >> 2), cp = (lane & 3) * 16;
#pragma unroll
            for (int i = 0; i < 2; ++i) *(v4u*)(GR + (size_t)(row_base + t0 + row) * DMODEL + c0 + cp + 8 * i) = *(const LAS v4u*)(GRS + row * 64 + cp + 8 * i); }
          hc = hend; }
    }
    if (wave == 0) hlast[c0 + lane] = hc;
    __syncthreads();
}
#ifndef MK_SPLIT
#define MK_SPLIT 0
#endif
__global__ void __launch_bounds__(NWAVES * 64, 2) fwd_megakernel(Params P) {
    extern __shared__ __attribute__((aligned(16))) unsigned char lds_raw[];
    LAS unsigned char* lds = (LAS unsigned char*)lds_raw;
    const int G = gridDim.x;
    const int wave0 = __builtin_amdgcn_readfirstlane(threadIdx.x >> 6);
#define TID_DEFS int tid_; asm volatile("v_mbcnt_lo_u32_b32 %0, -1, 0\n\tv_mbcnt_hi_u32_b32 %0, -1, %0" : "=v"(tid_)); tid_ += wave0 * 64; const int tid = tid_, lane = tid & 63, wave = __builtin_amdgcn_readfirstlane(tid >> 6); (void)lane; (void)wave
    cg::grid_group grid = cg::this_grid();
    unsigned char* ws = P.ws;
    bf16* HN = (bf16*)(ws + WS_HN); bf16* XR = (bf16*)(ws + WS_XR); bf16* GR = (bf16*)(ws + WS_GR); bf16* QB = (bf16*)(ws + WS_Q); bf16* KB = (bf16*)(ws + WS_K); bf16* VB = (bf16*)(ws + WS_V); bf16* GB = (bf16*)(ws + WS_G);
    const float* MOD = (const float*)(ws + WS_MOD); const float* MODF = (const float*)(ws + WS_MODF);
    unsigned char* GA8 = ws + WS_END; unsigned char* GB8 = ws + WS_END + (size_t)MT * DMODEL;
    float* X = P.out + O_Y;
#ifdef PH_ONLY
#define IN(k) ((k) == PH_ONLY)
#else
#define IN(k) (P.ph_lo <= (k) && (k) < P.ph_hi)
#endif
#define STAMP(k) do {} while (0)
#define SEAM(k) do { if (IN(k) && IN((k) + 1)) { { TID_DEFS; xcd_barrier(bar, tid); } } STAMP(k); } while (0)
    if (P.ph_lo < 0) grid.sync();
    XcdBarrier bar;
    { TID_DEFS; for (int u = tid; u < 64; u += NWAVES * 64) ((LAS unsigned*)(lds + LDS_BYTES - 256))[u] = 0u; __syncthreads();
      bar = xcd_barrier_post((unsigned*)(ws + WS_CTL), (volatile LAS unsigned*)(lds + LDS_BYTES - 256) + 8, tid); }
#define GEMM_PHASE(EPI, e, Aptr, Bptr, NN, KK) do { pg8::Gemm g_{(const pg8::bf16_t*)(Aptr), (const pg8::bf16_t*)(Bptr), MP, (NN), (KK)}; pg8::StaticOrder S_; S_.init(MP, (NN), G, (int)blockIdx.x); \
        TID_DEFS; pg8::gemm_phase<EPI, pg8::StaticOrder, true, true>(lds, g_, S_, e, tid); } while (0)

#define SAMPLE_GEMM(DUAL, se, Aptr, Bptr, NCB, KK) do { TID_DEFS; sg::sample_gemm<DUAL>((const pg8::bf16_t*)(Aptr), (const pg8::bf16_t*)(Bptr), (NCB), (KK), se, (int)blockIdx.x * NWAVES + wave, G * NWAVES, lane); } while (0)
    if (IN(0)) { TID_DEFS; p0_ada(P, lds, wave, lane, tid); } SEAM(0);
    if (IN(1)) { TID_DEFS; p0_prologue(P, lds, wave, lane, tid); norm_phase<false, false>(P.x_prompt, P.x_sample, nullptr, P.ffn1_norm, MOD, NMOD * DMODEL, 0, 1, HN, nullptr, wave, lane); } SEAM(1);
    if (IN(2)) { pg8::EpiSwiglu e{GB}; GEMM_PHASE(pg8::EpiSwiglu, e, HN, ws + WS_W13A, 2 * DFF, DMODEL); sg::SSwiglu se{GB}; SAMPLE_GEMM(true, se, HN, ws + WS_W13A, DFF / 16, DMODEL); } SEAM(2);
    if (IN(3)) { pg8::EpiResid<true> e{P.x_prompt, X, MOD, 2, 0.5f, HN}; GEMM_PHASE(pg8::EpiResid<true>, e, GB, ws + WS_W2A, DMODEL, DFF); sg::SResid<true> se{P.x_sample, X, MOD, 2, 0.5f, HN}; SAMPLE_GEMM(false, se, GB, ws + WS_W2A, DMODEL / 16, DFF); } SEAM(3);
    if (IN(4)) { TID_DEFS; norm_phase<false, true>(nullptr, nullptr, HN, P.mix_norm, MOD, NMOD * DMODEL, 3, 4, HN, nullptr, wave, lane); } SEAM(4);
    if (IN(5)) { pg8::EpiIn e{XR, GR, QB, KB, VB, P.out, P.b_fgt, attn_body::C2, GA8, GB8}; GEMM_PHASE(pg8::EpiIn, e, HN, ws + WS_WIN, 29 * 256, DMODEL); sg::SIn se{XR, GR, QB, KB, VB, P.out, P.b_fgt, attn_body::C2}; SAMPLE_GEMM(false, se, HN, ws + WS_WIN, 5136 / 16, DMODEL);
        sg::SGate sgt{GA8, GB8}; SAMPLE_GEMM(false, sgt, HN, ws + WS_WIN + (size_t)5376 * DMODEL * 2, 2048 / 16, DMODEL); } SEAM(5);

    if (IN(6)) {
#ifndef NO_ATTN
        for (int bh = blockIdx.x; bh < NB_P * NHEAD; bh += G) { TID_DEFS; const int b = bh >> 4, h = bh & 15;
            forget_table(P.out + O_LFP + (size_t)b * SEQ_P * NHEAD + h, NHEAD, nullptr, 0, (LAS float*)(lds + attn_body::LDS_NF), (LAS float*)(lds + attn_body::LDS_NFW), tid, lane, wave);
            for (int qb = 7; qb >= 0; --qb) attn_body::attn_unit<16>(b, h, qb, (const attn_body::bf16*)QB, (const attn_body::bf16*)KB, (const attn_body::bf16*)VB, (attn_body::bf16*)QB, (char*)lds_raw, tid);
            __syncthreads(); }
#endif
#ifndef NO_SATTN
        for (int u = blockIdx.x; u < NB_S * NHEAD; u += G) { TID_DEFS; sattn_unit(P, u >> 4, u & 15, lds, tid, lane, wave); }
#endif
#ifndef NO_RGLRU
        for (int it = blockIdx.x; it < NB_P * 16; it += G) { TID_DEFS; const int b = it >> 4, n = it & 15; rglru_item(P, b * SEQ_P, SEQ_P, n, nullptr, nullptr, P.out + O_HP + (size_t)b * DMODEL, lds, tid, lane, wave); }
        for (int it = blockIdx.x; it < NB_S * 16; it += G) { TID_DEFS; const int b = it >> 4, n = it & 15;
            rglru_item(P, MP + b * TS, TS, n, P.state_conv + (size_t)b * 3 * DMODEL, P.state_rglru + (size_t)b * DMODEL, P.out + O_HS + (size_t)b * DMODEL, lds, tid, lane, wave); }
#endif
    } SEAM(6);

    if (IN(8)) { pg8::EpiZ<false> e{GA8, VB}; GEMM_PHASE(pg8::EpiZ<false>, e, GR, ws + WS_WR, DMODEL, DMODEL); sg::SZ<false> se{GA8, VB}; SAMPLE_GEMM(false, se, GR, ws + WS_WR, DMODEL / 16, DMODEL); }
    if (IN(9)) { pg8::EpiZ<true> e{GB8, VB}; GEMM_PHASE(pg8::EpiZ<true>, e, QB, ws + WS_WA, DMODEL, DMODEL); sg::SZ<true> se{GB8, VB}; SAMPLE_GEMM(false, se, QB, ws + WS_WA, DMODEL / 16, DMODEL); } SEAM(9);
    if (IN(10)) { pg8::EpiResid<true> e{X, X, MOD, 5, 1.0f, HN}; GEMM_PHASE(pg8::EpiResid<true>, e, VB, ws + WS_WO, DMODEL, DMODEL); sg::SResid<true> se{X + (size_t)MP * DMODEL, X, MOD, 5, 1.0f, HN}; SAMPLE_GEMM(false, se, VB, ws + WS_WO, DMODEL / 16, DMODEL); } SEAM(10);
    if (IN(11)) { TID_DEFS; norm_phase<false, true>(nullptr, nullptr, HN, P.ffn2_norm, MOD, NMOD * DMODEL, 6, 7, HN, nullptr, wave, lane); } SEAM(11);
    if (IN(12)) { pg8::EpiSwiglu e{GB}; GEMM_PHASE(pg8::EpiSwiglu, e, HN, ws + WS_W13B, 2 * DFF, DMODEL); sg::SSwiglu se{GB}; SAMPLE_GEMM(true, se, HN, ws + WS_W13B, DFF / 16, DMODEL); } SEAM(12);
    if (IN(13)) { pg8::EpiResid<false> e{X, X, MOD, 8, 0.5f, HN}; GEMM_PHASE(pg8::EpiResid<false>, e, GB, ws + WS_W2B, DMODEL, DFF); sg::SResid<false> se{X + (size_t)MP * DMODEL, X, MOD, 8, 0.5f, HN}; SAMPLE_GEMM(false, se, GB, ws + WS_W2B, DMODEL / 16, DFF); } SEAM(13);
    if (IN(14)) { TID_DEFS; norm_phase<true, true>(nullptr, nullptr, HN, P.final_norm, MODF, 2 * DMODEL, 0, 1, nullptr, X, wave, lane); }

#undef IN
#undef SEAM
#undef GEMM_PHASE
#undef SAMPLE_GEMM
}

extern "C" void kernel_launch(void* const* d_in, const int* in_sizes, int n_in, void* d_out, int out_size, void* d_ws, size_t ws_size, hipStream_t stream) {
    static int grid = 0;
    if (grid == 0) {
        if (n_in != 35 || ws_size < WS_END) { fprintf(stderr, "kernel_launch: unexpected n_in %d / ws %zu\n", n_in, ws_size); grid = -1; return; }
        int dev = 0, cus = 0, per_cu = 0;
        hipGetDevice(&dev); hipDeviceGetAttribute(&cus, hipDeviceAttributeMultiprocessorCount, dev);
        if (hipFuncSetAttribute((const void*)fwd_megakernel, hipFuncAttributeMaxDynamicSharedMemorySize, LDS_BYTES) != hipSuccess) { fprintf(stderr, "kernel_launch: hipFuncSetAttribute failed\n"); grid = -1; return; }
        if (hipOccupancyMaxActiveBlocksPerMultiprocessor(&per_cu, (const void*)fwd_megakernel, NWAVES * 64, LDS_BYTES) != hipSuccess || per_cu < 1) { fprintf(stderr, "kernel_launch: occupancy query says %d\n", per_cu); per_cu = 1; }
        (void)hipGetLastError();
        grid = cus;
    }
    if (grid < 0) return;
    if (hipMemsetAsync((char*)d_ws + WS_CTL, 0, 65536, stream) != hipSuccess) { fprintf(stderr, "kernel_launch: memset failed\n"); return; }
    Params p{};
    const float** pp = (const float**)&p;
    for (int i = 0; i < 35; ++i) pp[i] = (const float*)d_in[i];
    p.out = (float*)d_out; p.ws = (unsigned char*)d_ws;
#if MK_SPLIT
    for (int ph = 0; ph < NPHASE; ++ph) { p.ph_lo = ph; p.ph_hi = ph + 1; void* args[] = {&p};
        hipError_t e = hipLaunchCooperativeKernel((const void*)fwd_megakernel, dim3(grid), dim3(NWAVES * 64), args, LDS_BYTES, stream);
        if (e != hipSuccess) { fprintf(stderr, "cooperative launch (phase %d) failed: %s\n", ph, hipGetErrorString(e)); break; } }
#else
    p.ph_lo = 0; p.ph_hi = NPHASE; void* args[] = {&p};
    hipError_t e = hipLaunchCooperativeKernel((const void*)fwd_megakernel, dim3(grid), dim3(NWAVES * 64), args, LDS_BYTES, stream);
    if (e != hipSuccess) fprintf(stderr, "cooperative launch failed: %s (grid %d)\n", hipGetErrorString(e), grid);
#endif
}
```

```cpp
#include <hip/hip_runtime.h>
#include <hip/hip_cooperative_groups.h>
#include <hip/hip_bf16.h>
#include <cstdio>
#include <cstdint>
#include <cmath>
namespace cg = cooperative_groups;

constexpr int DMODEL = 1024, MP = 65536, MS = 256, MT = MP + MS, SEQ_P = 2048, NB_P = 32, NB_S = 16, TS = 16, PAST = 2048;
constexpr int DFF = 2816, NHEAD = 16, NMOD = 9, INCOLS = 7184;
constexpr int NBT = NB_P + NB_S;
__device__ __forceinline__ int batch_of_row(int r) { return r < MP ? (r >> 11) : NB_P + ((r - MP) >> 4); }

namespace pg8 {
#define PG8_LAS __attribute__((address_space(3)))
typedef unsigned short bf16_t;
typedef short bf16x8 __attribute__((ext_vector_type(8)));
typedef float f32x4 __attribute__((ext_vector_type(4)));
typedef unsigned u32x4 __attribute__((ext_vector_type(4)));
typedef unsigned u32x2 __attribute__((ext_vector_type(2)));
constexpr int BM = 256, BK = 64, HALF = 128, HTB = HALF * BK * 2  , STAGE_BYTES = 8 * HTB, NXCD = 8, WGM = 4;

__host__ __device__ __forceinline__ int lds_byte(int r, int c) { const int st = (r >> 4) * 2 + (c >> 5), rr = r & 15, cc = c & 31, ob = rr * 64 + cc * 2; return st * 1024 + (ob ^ (((ob >> 9) & 1) << 5)); }
__host__ __device__ __forceinline__ void stage_rc(int b, int& R, int& C) { const int st = b / 1024, sb = b % 1024, swz = sb ^ (((sb >> 9) & 1) << 5); R = (st >> 1) * 16 + swz / 64; C = (st & 1) * 32 + (swz % 64) / 2; }
__host__ __device__ __forceinline__ int perm32(int rho) { const int n = rho >> 4, i = rho & 15; return 8 * (i >> 2) + 4 * n + (i & 3); }

struct Unit { int pm, pn; };
struct Gemm { const bf16_t* A; const bf16_t* Bt; int M, N, K; };

struct StaticOrder {
    int nM, nN, nwg, G, c;
    __host__ __device__ void init(int M, int N, int G_, int c_) { nM = M / BM; nN = N / BM; nwg = nM * nN; G = G_; c = c_; }
    __host__ __device__ bool next(int i, Unit& u) const {
        const long L = (long)i * G + c; if (L >= nwg) return false;
        int wgid = (int)L; { const int q = nwg / NXCD, r = nwg % NXCD, xcd = wgid % NXCD, off = wgid / NXCD; wgid = (xcd < r ? xcd * (q + 1) : r * (q + 1) + (xcd - r) * q) + off; }
        const int nig = WGM * nN, gid = wgid / nig, fm = gid * WGM, gsz = (nM - fm) < WGM ? (nM - fm) : WGM;
        u.pm = fm + ((wgid % nig) % gsz); u.pn = (wgid % nig) / gsz; return true;
    }
    __device__ __forceinline__ void a_ready(const Unit&) const {}
    __device__ __forceinline__ void done(const Unit&) const {}
};

typedef float f32x2c_t __attribute__((ext_vector_type(2))); typedef __bf16 bf16x2c_t __attribute__((ext_vector_type(2)));
__device__ __forceinline__ unsigned cvt_pk_bf16(float lo, float hi) { const f32x2c_t v = {lo, hi}; const bf16x2c_t b = __builtin_convertvector(v, bf16x2c_t); return __builtin_bit_cast(unsigned, b); }
__device__ __forceinline__ float bf_lo(unsigned w) { return __uint_as_float(w << 16); }
__device__ __forceinline__ float bf_hi(unsigned w) { return __uint_as_float(w & 0xffff0000u); }
__device__ __forceinline__ float sigmoid_f(float x) { return __builtin_amdgcn_rcpf(1.0f + __builtin_amdgcn_exp2f(-1.4426950408889634f * x)); }
__device__ __forceinline__ float silu_f(float x) { return x * sigmoid_f(x); }
__device__ __forceinline__ float gelu_tanh_f(float x) { const float y = 1.5957691216057308f * (x + 0.044715f * x * x * x); return x * sigmoid_f(y); }
__device__ __forceinline__ u32x4 pack8(f32x4 a, f32x4 b) { u32x4 w; w.x = cvt_pk_bf16(a[0], a[1]); w.y = cvt_pk_bf16(a[2], a[3]); w.z = cvt_pk_bf16(b[0], b[1]); w.w = cvt_pk_bf16(b[2], b[3]); return w; }
__device__ __forceinline__ int epi_batch(const Unit& u, int ai, int wr, int m) { return u.pm < 256 ? (u.pm >> 3) : NB_P + 8 * ai + 4 * wr + m; }

__device__ __forceinline__ unsigned gate4(f32x4 v) { unsigned w = 0;
#pragma unroll
    for (int i = 0; i < 4; ++i) w |= (unsigned)(sigmoid_f(v[i]) * 255.0f + 0.5f) << (8 * i);
    return w; }
__device__ __forceinline__ f32x4 ungate4(unsigned w) { return (f32x4){(float)(w & 255u), (float)((w >> 8) & 255u), (float)((w >> 16) & 255u), (float)(w >> 24)} * (1.0f / 255.0f); }
struct EpiSwiglu {
    static constexpr bool PERM = true, AFTER_DRAIN = false;
    bf16_t* G;
    __device__ __forceinline__ void operator()(const f32x4 (&acc)[2][2][4][2], const Unit& u, int wr, int wc, int fr, int fq) const {
        const int row0 = u.pm * BM + wr * 64 + fr, col0 = u.pn * HALF + wc * 32 + 8 * fq;
#pragma unroll
        for (int ai = 0; ai < 2; ++ai)
#pragma unroll
            for (int m = 0; m < 4; ++m) { bf16_t* rowp = G + (size_t)(row0 + ai * HALF + m * 16) * DFF + col0;
                const f32x4 a0 = acc[ai][0][m][0], a1 = acc[ai][0][m][1], b0 = acc[ai][1][m][0], b1 = acc[ai][1][m][1];
                f32x4 v0, v1;
#pragma unroll
                for (int i = 0; i < 4; ++i) { v0[i] = silu_f(a0[i]) * b0[i]; v1[i] = silu_f(a1[i]) * b1[i]; }
                *(u32x4*)rowp = pack8(v0, v1); }
    }
};

template <bool WF32> struct EpiResid {
    static constexpr bool PERM = true, AFTER_DRAIN = false;
    const float* base; float* out; const float* mod; int jmod; float mult; bf16_t* XB;
    __device__ __forceinline__ void operator()(const f32x4 (&acc)[2][2][4][2], const Unit& u, int wr, int wc, int fr, int fq) const {
        const int col0 = u.pn * BM + wc * 32 + 8 * fq; const float* mp = mod + (size_t)(u.pm >> 3) * (NMOD * DMODEL) + jmod * DMODEL + col0;
#pragma unroll
        for (int ai = 0; ai < 2; ++ai)
#pragma unroll
            for (int m = 0; m < 4; ++m) { const size_t ro = (size_t)(u.pm * BM + ai * HALF + wr * 64 + m * 16 + fr) * DMODEL + col0;
#pragma unroll
                for (int bj = 0; bj < 2; ++bj) { const int o = bj * HALF;
                    const f32x4 o0 = *(const f32x4*)(base + ro + o) + (*(const f32x4*)(mp + o) + 1.0f) * mult * acc[ai][bj][m][0];
                    const f32x4 o1 = *(const f32x4*)(base + ro + o + 4) + (*(const f32x4*)(mp + o + 4) + 1.0f) * mult * acc[ai][bj][m][1];
                    if (WF32) { *(f32x4*)(out + ro + o) = o0; *(f32x4*)(out + ro + o + 4) = o1; }
                    *(u32x4*)(XB + ro + o) = pack8(o0, o1); } }
    }
};

struct EpiIn {
    static constexpr bool PERM = true, AFTER_DRAIN = false;
    bf16_t *XR, *GR, *Q, *K, *V; float* dout; const float* bfgt; float qscale; unsigned char *GA8, *GB8;
    __device__ __forceinline__ void operator()(const f32x4 (&acc)[2][2][4][2], const Unit& u, int wr, int wc, int fr, int fq) const {
        if (u.pn >= 21) {
            const int gi = u.pn - 21; unsigned char* dst = (gi < 4) ? GA8 : GB8; const int c0 = (gi & 3) * BM + wc * 32 + 8 * fq;
#pragma unroll
            for (int ai = 0; ai < 2; ++ai)
#pragma unroll
                for (int m = 0; m < 4; ++m) { unsigned char* rowp = dst + (size_t)(u.pm * BM + ai * HALF + wr * 64 + m * 16 + fr) * DMODEL + c0;
#pragma unroll
                    for (int bj = 0; bj < 2; ++bj) *(u32x2*)(rowp + bj * HALF) = (u32x2){gate4(acc[ai][bj][m][0]), gate4(acc[ai][bj][m][1])}; }
            return; }
        const int reg = u.pn >> 2, colt = (u.pn & 3) * BM, col0 = colt + wc * 32 + 8 * fq;
        if (u.pn == 20) {
            if (wc == 0 && fq < 2) {
#pragma unroll
                for (int ai = 0; ai < 2; ++ai)
#pragma unroll
                    for (int m = 0; m < 4; ++m) { const int row = u.pm * BM + ai * HALF + wr * 64 + m * 16 + fr;
                        float* lp = dout + (row < MP ? (size_t)201588736 + (size_t)row * NHEAD : (size_t)203292672 + (size_t)(row - MP) * NHEAD) + 8 * fq;
#pragma unroll
                        for (int n = 0; n < 2; ++n) { f32x4 x = acc[ai][0][m][n] + *(const f32x4*)(bfgt + 8 * fq + 4 * n), o;
#pragma unroll
                            for (int i = 0; i < 4; ++i) o[i] = fminf(x[i], 0.f) - log1pf(__expf(-fabsf(x[i])));
                            *(f32x4*)(lp + 4 * n) = o; } }
            }
            return;
        }
        bf16_t* dst = reg == 0 ? XR : reg == 1 ? GR : reg == 2 ? Q : reg == 3 ? K : V;
#pragma unroll
        for (int ai = 0; ai < 2; ++ai)
#pragma unroll
            for (int m = 0; m < 4; ++m) { const int row = u.pm * BM + ai * HALF + wr * 64 + m * 16 + fr; bf16_t* rowp = dst + (size_t)row * DMODEL + col0;
#pragma unroll
                for (int bj = 0; bj < 2; ++bj) { f32x4 v0 = acc[ai][bj][m][0], v1 = acc[ai][bj][m][1];
                    if (reg == 1) {
#pragma unroll
                        for (int i = 0; i < 4; ++i) { v0[i] = gelu_tanh_f(v0[i]); v1[i] = gelu_tanh_f(v1[i]); } }
                    else if (reg == 2) { v0 = v0 * qscale; v1 = v1 * qscale; }
                    else if (reg >= 3) {
                        float* op = dout + (reg == 3 ? (row < MP ? (size_t)67371008 : (size_t)202768384) : (row < MP ? (size_t)134479872 : (size_t)203030528))
                                    + (size_t)(row < MP ? row : row - MP) * DMODEL + col0 + bj * HALF;
                        *(f32x4*)op = v0; *(f32x4*)(op + 4) = v1; }
                    else {
                        int t, b; if (row < MP) { t = (row & 2047) - 2045; b = row >> 11; } else { t = ((row - MP) & 15) - 13; b = (row - MP) >> 4; }
                        if (t >= 0) { float* op = dout + (row < MP ? (size_t)202637312 : (size_t)203296768) + ((size_t)b * 3 + t) * DMODEL + col0 + bj * HALF;
                            *(f32x4*)op = v0; *(f32x4*)(op + 4) = v1; } }
                    *(u32x4*)(rowp + bj * HALF) = pack8(v0, v1); } }
    }
};

template <bool ADD> struct EpiZ {
    static constexpr bool PERM = true, AFTER_DRAIN = false;
    const unsigned char* GATE; bf16_t* Z;
    __device__ __forceinline__ void operator()(const f32x4 (&acc)[2][2][4][2], const Unit& u, int wr, int wc, int fr, int fq) const {
        const int col0 = u.pn * BM + wc * 32 + 8 * fq;
#pragma unroll
        for (int ai = 0; ai < 2; ++ai)
#pragma unroll
            for (int m = 0; m < 4; ++m) { const int row = u.pm * BM + ai * HALF + wr * 64 + m * 16 + fr; const size_t off = (size_t)row * DMODEL + col0;
#pragma unroll
                for (int bj = 0; bj < 2; ++bj) { const u32x2 g = *(const u32x2*)(GATE + off + bj * HALF); f32x4 v0 = acc[ai][bj][m][0] * ungate4(g.x), v1 = acc[ai][bj][m][1] * ungate4(g.y);
                    if (ADD) { const u32x4 z = *(const u32x4*)(Z + off + bj * HALF);
                        v0[0] += bf_lo(z.x); v0[1] += bf_hi(z.x); v0[2] += bf_lo(z.y); v0[3] += bf_hi(z.y); v1[0] += bf_lo(z.z); v1[1] += bf_hi(z.z); v1[2] += bf_lo(z.w); v1[3] += bf_hi(z.w); }
                    *(u32x4*)(Z + off + bj * HALF) = pack8(v0, v1); } }
    }
};

template <class Epi, class Sched, bool ALIGN_EPI = false, bool SP2 = false>
__device__ __forceinline__ void gemm_phase(PG8_LAS unsigned char* lds, const Gemm g, const Sched& S, const Epi& E, const int tid) {
    const int wid = __builtin_amdgcn_readfirstlane(tid >> 6), lane = tid & 63, wr = wid >> 2, wc = wid & 3, fr = lane & 15, fq = lane >> 4;
    const int K = g.K, nt = K / BK;
    unsigned voffA[2], voffB[2];
#pragma unroll
    for (int i = 0; i < 2; ++i) { int R, C; stage_rc(tid * 16 + i * 8192, R, C); const int Rb = Epi::PERM ? ((R & ~31) + perm32(R & 31)) : R;
        voffA[i] = (unsigned)(R * K + C) * 2u; voffB[i] = (unsigned)(Rb * K + C) * 2u; }
    const size_t kstep = (size_t)(BK * 2);
    const size_t hstep = (size_t)HALF * K * 2;
    const size_t tstep = 2 * hstep;
    const unsigned ldsw = (unsigned)wid * 1024u;
    const int aoff = lds_byte(wr * 64 + fr, fq * 8), boff = lds_byte(wc * 32 + fr, fq * 8);
#define PG8_SA(b, h) (((b) * 2 + (h)) * HTB)
#define PG8_SB(b, h) ((4 + (b) * 2 + (h)) * HTB)
#define PG8_STAGE(bufoff, gbase, voff) do { _Pragma("unroll") for (int _i = 0; _i < 2; ++_i) \
        __builtin_amdgcn_global_load_lds((const unsigned*)((const char*)(gbase) + (voff)[_i]), (PG8_LAS unsigned*)(lds + (bufoff) + ldsw + _i * 8192), 16, 0, 0); } while (0)
#define PG8_LDA(dst, b, h) do { _Pragma("unroll") for (int m = 0; m < 4; ++m) _Pragma("unroll") for (int k = 0; k < 2; ++k) dst[m][k] = *(const PG8_LAS bf16x8*)(lds + PG8_SA(b, h) + aoff + m * 2048 + k * 1024); } while (0)
#define PG8_LDB(dst, b, h) do { _Pragma("unroll") for (int n = 0; n < 2; ++n) _Pragma("unroll") for (int k = 0; k < 2; ++k) dst[n][k] = *(const PG8_LAS bf16x8*)(lds + PG8_SB(b, h) + boff + n * 2048 + k * 1024); } while (0)
#define PG8_MMA(ai, bj, At, Bt) do { __builtin_amdgcn_s_setprio(1); _Pragma("unroll") for (int m = 0; m < 4; ++m) _Pragma("unroll") for (int n = 0; n < 2; ++n) _Pragma("unroll") for (int k = 0; k < 2; ++k) \
        acc[ai][bj][m][n] = __builtin_amdgcn_mfma_f32_16x16x32_bf16(Bt[n][k], At[m][k], acc[ai][bj][m][n], 0, 0, 0); __builtin_amdgcn_s_setprio(0); } while (0)
#define PG8_WAIT_V(n) asm volatile("s_waitcnt vmcnt(" #n ")" ::: "memory")
#define PG8_WAIT_L(n) asm volatile("s_waitcnt lgkmcnt(" #n ")" ::: "memory")
#define PG8_BAR __builtin_amdgcn_s_barrier()
#define PG8_SCHED __builtin_amdgcn_sched_barrier(0)
    Unit cur, nxt; int ui = 0;
    if (!S.next(0, cur)) return;
    f32x4 acc[2][2][4][2];
#pragma unroll
    for (int a = 0; a < 2; ++a)
#pragma unroll
        for (int b = 0; b < 2; ++b)
#pragma unroll
            for (int m = 0; m < 4; ++m)
#pragma unroll
                for (int n = 0; n < 2; ++n) acc[a][b][m][n] = (f32x4){0.f, 0.f, 0.f, 0.f};
    bf16x8 At[4][2], B0[2][2], B1[2][2];
    const char* cA = (const char*)g.A + (size_t)cur.pm * tstep; const char* cB = (const char*)g.Bt + (size_t)cur.pn * tstep;
    S.a_ready(cur);
    if constexpr (SP2) {
        PG8_STAGE(PG8_SB(0, 0), cB, voffB); PG8_STAGE(PG8_SB(0, 1), cB + hstep, voffB); PG8_STAGE(PG8_SA(0, 0), cA, voffA); PG8_STAGE(PG8_SA(0, 1), cA + hstep, voffA);
        if (wr == 1) PG8_BAR;
        PG8_WAIT_V(2); PG8_BAR;
        PG8_STAGE(PG8_SB(1, 0), cB + kstep, voffB); PG8_STAGE(PG8_SA(1, 0), cA + kstep, voffA); PG8_STAGE(PG8_SB(1, 1), cB + hstep + kstep, voffB);
        PG8_WAIT_V(6); PG8_BAR;
    } else {
        PG8_STAGE(PG8_SB(0, 0), cB, voffB); PG8_STAGE(PG8_SA(0, 0), cA, voffA); PG8_STAGE(PG8_SB(0, 1), cB + hstep, voffB); PG8_STAGE(PG8_SA(0, 1), cA + hstep, voffA);
        if (wr == 1) PG8_BAR;
        PG8_WAIT_V(4); PG8_BAR;
        PG8_STAGE(PG8_SB(1, 0), cB + kstep, voffB); PG8_STAGE(PG8_SA(1, 0), cA + kstep, voffA); PG8_STAGE(PG8_SB(1, 1), cB + hstep + kstep, voffB);
        PG8_WAIT_V(6); PG8_BAR;
    }
    for (;;) {
        const bool has_next = S.next(ui + 1, nxt);
        const char* nA = has_next ? (const char*)g.A + (size_t)nxt.pm * tstep : cA; const char* nB = has_next ? (const char*)g.Bt + (size_t)nxt.pn * tstep : cB;
        for (int t = 0; t < nt; t += 2) {
            const bool last = (t == nt - 2);
            const char* a1 = cA + (size_t)(t + 1) * kstep;
            const char* a2 = last ? nA : cA + (size_t)(t + 2) * kstep; const char* b2 = last ? nB : cB + (size_t)(t + 2) * kstep;
            const char* a3 = a2 + kstep; const char* b3 = b2 + kstep;
            if (last && has_next) S.a_ready(nxt);
            if constexpr (SP2) {
            PG8_LDB(B0, 0, 0); PG8_LDB(B1, 0, 1); PG8_SCHED; PG8_LDA(At, 0, 0); PG8_STAGE(PG8_SA(1, 1), a1 + hstep, voffA);
            PG8_WAIT_V(8); PG8_WAIT_L(0); PG8_BAR; PG8_MMA(0, 0, At, B0); PG8_MMA(0, 1, At, B1); PG8_BAR; PG8_SCHED;
            PG8_LDA(At, 0, 1); PG8_STAGE(PG8_SB(0, 0), b2, voffB); PG8_STAGE(PG8_SB(0, 1), b2 + hstep, voffB); PG8_STAGE(PG8_SA(0, 0), a2, voffA);
            PG8_WAIT_V(8); PG8_WAIT_L(0); PG8_BAR; PG8_MMA(1, 0, At, B0); PG8_MMA(1, 1, At, B1); PG8_BAR; PG8_SCHED;
            PG8_LDB(B0, 1, 0); PG8_LDB(B1, 1, 1); PG8_SCHED; PG8_LDA(At, 1, 0); PG8_STAGE(PG8_SA(0, 1), a2 + hstep, voffA);
            PG8_WAIT_V(8); PG8_WAIT_L(0); PG8_BAR; PG8_MMA(0, 0, At, B0); PG8_MMA(0, 1, At, B1); PG8_BAR; PG8_SCHED;
            PG8_LDA(At, 1, 1); PG8_STAGE(PG8_SB(1, 0), b3, voffB); PG8_STAGE(PG8_SB(1, 1), b3 + hstep, voffB); PG8_STAGE(PG8_SA(1, 0), a3, voffA);
            PG8_WAIT_V(8); PG8_WAIT_L(0); PG8_BAR; PG8_MMA(1, 0, At, B0); PG8_MMA(1, 1, At, B1); PG8_BAR; PG8_SCHED;
            } else {
            PG8_LDB(B0, 0, 0); PG8_SCHED; PG8_LDA(At, 0, 0); PG8_STAGE(PG8_SA(1, 1), a1 + hstep, voffA);
            PG8_WAIT_L(8); PG8_BAR; PG8_WAIT_L(0); PG8_MMA(0, 0, At, B0); PG8_BAR; PG8_SCHED;
            PG8_LDB(B1, 0, 1); PG8_STAGE(PG8_SB(0, 0), b2, voffB);
            PG8_BAR; PG8_WAIT_L(0); PG8_MMA(0, 1, At, B1); PG8_BAR;
            PG8_LDA(At, 0, 1); PG8_STAGE(PG8_SA(0, 0), a2, voffA);
            PG8_BAR; PG8_WAIT_L(0); PG8_MMA(1, 0, At, B0); PG8_BAR; PG8_SCHED;
            PG8_STAGE(PG8_SB(0, 1), b2 + hstep, voffB);
            PG8_WAIT_V(6); PG8_BAR; PG8_MMA(1, 1, At, B1); PG8_BAR;
            PG8_LDB(B0, 1, 0); PG8_SCHED; PG8_LDA(At, 1, 0); PG8_STAGE(PG8_SA(0, 1), a2 + hstep, voffA);
            PG8_WAIT_L(8); PG8_BAR; PG8_WAIT_L(0); PG8_MMA(0, 0, At, B0); PG8_BAR; PG8_SCHED;
            PG8_LDB(B1, 1, 1); PG8_STAGE(PG8_SB(1, 0), b3, voffB);
            PG8_BAR; PG8_WAIT_L(0); PG8_MMA(0, 1, At, B1); PG8_BAR;
            PG8_LDA(At, 1, 1); PG8_STAGE(PG8_SA(1, 0), a3, voffA);
            PG8_BAR; PG8_WAIT_L(0); PG8_MMA(1, 0, At, B0); PG8_BAR; PG8_SCHED;
            PG8_STAGE(PG8_SB(1, 1), b3 + hstep, voffB);
            PG8_WAIT_V(6); PG8_BAR; PG8_MMA(1, 1, At, B1); PG8_BAR;
            }
        }
        if constexpr (ALIGN_EPI) { if (wr == 0) PG8_BAR; }
        if constexpr (!Epi::AFTER_DRAIN) { E(acc, cur, wr, wc, fr, fq); S.done(cur); }
        if (!has_next) break;
#pragma unroll
        for (int a = 0; a < 2; ++a)
#pragma unroll
            for (int b = 0; b < 2; ++b)
#pragma unroll
                for (int m = 0; m < 4; ++m)
#pragma unroll
                    for (int n = 0; n < 2; ++n) acc[a][b][m][n] = (f32x4){0.f, 0.f, 0.f, 0.f};
        cur = nxt; cA = nA; cB = nB; ++ui;
        if constexpr (ALIGN_EPI) { if (wr == 1) PG8_BAR; }
    }
    PG8_WAIT_V(0);
    if constexpr (!ALIGN_EPI) { if (wr == 0) PG8_BAR; }
    PG8_BAR;
    if constexpr (Epi::AFTER_DRAIN) { E.fused(acc, cur, wr, wc, fr, fq, lds, wid, lane); S.done(cur); }
#undef PG8_SA
#undef PG8_SB
#undef PG8_STAGE
#undef PG8_LDA
#undef PG8_LDB
#undef PG8_MMA
#undef PG8_WAIT_V
#undef PG8_WAIT_L
#undef PG8_BAR
#undef PG8_SCHED
}
}

namespace attn_body {
using bf16=__hip_bfloat16;
using bf16x8=__attribute__((ext_vector_type(8)))short;
using s16x4=__attribute__((ext_vector_type(4)))short;
using f32x16=__attribute__((ext_vector_type(16)))float;
using u32x4=__attribute__((ext_vector_type(4)))unsigned;
using f32x4v=__attribute__((ext_vector_type(4)))float;
constexpr int BATCH=32,NHEAD=16,SEQ=2048,D=64,DM=NHEAD*D;
constexpr int NW=8,QBLK=32,QB=QBLK*NW,KVBLK=64,NQB=SEQ/QB;
constexpr int ATTN_PITCH=DM, ATTN_UNIT_ROWS=QB;
__device__ __forceinline__ int crow(int r,int hi){return (r&3)+8*(r>>2)+4*hi;}
#define SBAR() __builtin_amdgcn_sched_barrier(0)
__device__ __forceinline__ void cmask(f32x16&p0,f32x16&p1,int jb,int qrel,int hi){
  asm volatile("":"+v"(hi));
  const float NEG=-INFINITY; int kb=64*jb+4*hi;
  #pragma unroll
  for(int r=0;r<16;++r){int kv=kb+(r&3)+8*(r>>2); if(kv>qrel)p0[r]=NEG; if(kv+32>qrel)p1[r]=NEG;}
}

constexpr int NSLOT=3, SLOTB=8192;
constexpr int LDS_K=0, LDS_V=NSLOT*SLOTB, LDS_WS=2*NSLOT*SLOTB, LDS_OST=LDS_WS+NW*64*4, LDS_BYTES=LDS_OST+NW*4096;
constexpr int LDS_NF=86016, LDS_NFW=LDS_NF+8192;
constexpr float C2=0.125f*1.4426950408889634f;
__device__ __forceinline__ void glds16(const void*gsrc,unsigned lds_dst){unsigned keep;
  asm volatile("s_mov_b32 %0, m0\n\ts_mov_b32 m0, %2\n\ts_nop 0\n\tglobal_load_lds_dwordx4 %1, off\n\ts_mov_b32 m0, %0":"=&s"(keep):"v"(gsrc),"s"(lds_dst):"memory");}
__device__ __forceinline__ float max3f(float a,float b,float c){float r;asm("v_max3_f32 %0, %1, %2, %3":"=v"(r):"v"(a),"v"(b),"v"(c));return r;}
__device__ __forceinline__ float max2f(float a,float b){float r;asm("v_max_f32_e32 %0, %1, %2":"=v"(r):"v"(a),"v"(b));return r;}
__device__ __forceinline__ float fadd_s(float a,float b){float r;asm("v_add_f32_e32 %0, %1, %2":"=v"(r):"v"(a),"v"(b));return r;}
__device__ __forceinline__ float fsub_s(float a,float b){float r;asm("v_sub_f32_e32 %0, %1, %2":"=v"(r):"v"(a),"v"(b));return r;}
typedef float f32x2_t __attribute__((ext_vector_type(2))); typedef __bf16 bf16x2_t __attribute__((ext_vector_type(2)));
__device__ __forceinline__ unsigned cvtpk_s(float lo,float hi){f32x2_t v={lo,hi};bf16x2_t b=__builtin_convertvector(v,bf16x2_t);return __builtin_bit_cast(unsigned,b);}
#define WAIT_BAR(N) asm volatile("s_waitcnt vmcnt(" #N ") lgkmcnt(0)\n\ts_barrier":::"memory")

__device__ __forceinline__ void qkt(f32x16&p0,f32x16&p1,const char*Kslot,const bf16x8*qr,const f32x16&negm,int r32,int hi){
  const char*kb=Kslot+hi*1024+r32*16;
  #pragma unroll
  for(int d0=0;d0<4;++d0){
    const bf16x8 b0=*reinterpret_cast<const bf16x8*>(kb+d0*2048);
    const bf16x8 b1=*reinterpret_cast<const bf16x8*>(kb+d0*2048+512);
    if(d0==0){p0=__builtin_amdgcn_mfma_f32_32x32x16_bf16(b0,qr[0],negm,0,0,0);p1=__builtin_amdgcn_mfma_f32_32x32x16_bf16(b1,qr[0],negm,0,0,0);}
    else{p0=__builtin_amdgcn_mfma_f32_32x32x16_bf16(b0,qr[d0],p0,0,0,0);p1=__builtin_amdgcn_mfma_f32_32x32x16_bf16(b1,qr[d0],p1,0,0,0);}}
}
typedef __attribute__((address_space(3))) const char* lds_cptr;
typedef short v4i16_t __attribute__((ext_vector_type(4)));
__device__ __forceinline__ void kload8(bf16x8*kf,lds_cptr kp){
  kf[0]=*(const __attribute__((address_space(3))) bf16x8*)(kp);      kf[1]=*(const __attribute__((address_space(3))) bf16x8*)(kp+512);
  kf[2]=*(const __attribute__((address_space(3))) bf16x8*)(kp+2048); kf[3]=*(const __attribute__((address_space(3))) bf16x8*)(kp+2560);
  kf[4]=*(const __attribute__((address_space(3))) bf16x8*)(kp+4096); kf[5]=*(const __attribute__((address_space(3))) bf16x8*)(kp+4608);
  kf[6]=*(const __attribute__((address_space(3))) bf16x8*)(kp+6144); kf[7]=*(const __attribute__((address_space(3))) bf16x8*)(kp+6656);
}
__device__ __forceinline__ void kload2(bf16x8*kf,lds_cptr kp,int j){ kf[2*j]=*(const __attribute__((address_space(3))) bf16x8*)(kp+j*2048); kf[2*j+1]=*(const __attribute__((address_space(3))) bf16x8*)(kp+j*2048+512); }
__device__ __forceinline__ s16x4 vtr(lds_cptr p){ return __builtin_bit_cast(s16x4,__builtin_amdgcn_ds_read_tr16_b64_v4i16((__attribute__((address_space(3))) v4i16_t*)p)); }
__device__ __forceinline__ float rowmax(const f32x16&p0,const f32x16&p1){
  float a=max3f(p0[0],p0[1],p1[0]),b=max3f(p0[2],p0[3],p1[1]);a=max3f(a,p1[2],p1[3]);
  #pragma unroll
  for(int r=4;r<16;r+=4){a=max3f(a,p0[r],p0[r+1]);b=max3f(b,p0[r+2],p0[r+3]);a=max3f(a,p1[r],p1[r+1]);b=max3f(b,p1[r+2],p1[r+3]);}
  const float m=max2f(a,b);
  auto rr=__builtin_amdgcn_permlane32_swap(__float_as_uint(m),__float_as_uint(m),false,false);
  return max2f(__uint_as_float(rr[0]),__uint_as_float(rr[1]));
}
__device__ __forceinline__ void pv(f32x16*o,int vb,bf16x8 pa0,bf16x8 pa1,bf16x8 pa2,bf16x8 pa3){
  #pragma unroll
  for(int d0=0;d0<2;++d0){s16x4 lo[4],hi[4];
    #pragma unroll
    for(int ks=0;ks<4;++ks){
      asm volatile("ds_read_b64_tr_b16 %0,%1 offset:%c2":"=&v"(lo[ks]):"v"(vb),"i"(d0*4096+ks*1024):"memory");
      asm volatile("ds_read_b64_tr_b16 %0,%1 offset:%c2":"=&v"(hi[ks]):"v"(vb),"i"(d0*4096+ks*1024+512):"memory");}
    asm volatile("s_waitcnt lgkmcnt(0)":::"memory");SBAR();
    #define PK(k) (bf16x8){lo[k][0],lo[k][1],lo[k][2],lo[k][3],hi[k][0],hi[k][1],hi[k][2],hi[k][3]}
    o[d0]=__builtin_amdgcn_mfma_f32_32x32x16_bf16(pa0,PK(0),o[d0],0,0,0);
    o[d0]=__builtin_amdgcn_mfma_f32_32x32x16_bf16(pa1,PK(1),o[d0],0,0,0);
    o[d0]=__builtin_amdgcn_mfma_f32_32x32x16_bf16(pa2,PK(2),o[d0],0,0,0);
    o[d0]=__builtin_amdgcn_mfma_f32_32x32x16_bf16(pa3,PK(3),o[d0],0,0,0);
    #undef PK
  }
}

#ifndef ATTN_STORE16
#define ATTN_STORE16(p,v) (*(u32x4*)(p)=(v))
#endif
template<int THRL> __device__ __forceinline__ void attn_unit(int b,int h,int qb,const bf16*Q,const bf16*__restrict__ K,const bf16*__restrict__ V,bf16*O,char*shm,int tid_){
  asm volatile("":"+v"(tid_));
  const int tid=tid_,lane=tid&63,r32=lane&31,hi=lane>>5; const int wid=__builtin_amdgcn_readfirstlane(tid>>6);
  const long rowbase=(long)b*SEQ; const int q0=qb*QB;
  const bf16*Qw=Q+(rowbase+q0+wid*QBLK)*DM+h*D;
  const bf16*Kh=K+rowbase*DM+h*D,*Vh=V+rowbase*DM+h*D;
  const unsigned lds0=(unsigned)(uintptr_t)shm;
  float*wsf=(float*)(shm+LDS_WS)+wid*64;
  const bf16*ksrc=Kh+(long)lane*DM+wid*8;
  const bf16*vsrc=Vh+(long)(16*(wid&3)+(lane>>2))*DM+(wid>>2)*32+(lane&3)*8;
  const unsigned kdst=lds0+LDS_K+wid*1024, vdst=lds0+LDS_V+wid*1024;
  #define DMA_K(t,slot) glds16(ksrc+(long)(t)*KVBLK*DM,(unsigned)__builtin_amdgcn_readfirstlane(kdst+(slot)))
  #define DMA_V(t,slot) glds16(vsrc+(long)(t)*KVBLK*DM,(unsigned)__builtin_amdgcn_readfirstlane(vdst+(slot)))
  const int vb0=(int)(lds0+LDS_V)+((lane>>4)&1)*32+(lane&3)*8+(4*hi+((lane&15)>>2))*64;
  const char*Kbase=shm+LDS_K; bf16x8 kf[8];
  const lds_cptr shm3=(lds_cptr)shm; const lds_cptr kp0=shm3+LDS_K+hi*1024+r32*16; const lds_cptr vp0=shm3+LDS_V+((lane>>4)&1)*32+(lane&3)*8+(4*hi+((lane&15)>>2))*64;
  const int NT=(q0+QB)/KVBLK;
  DMA_K(0,0);DMA_V(0,0);DMA_K(1,SLOTB);
  bf16x8 qr[4];
  #pragma unroll
  for(int d0=0;d0<4;++d0)qr[d0]=*reinterpret_cast<const bf16x8*>(&Qw[(long)r32*DM+d0*16+hi*8]);
  float mhat=0.f,l_reg=0.f;f32x16 o[2]; { float z_=0.f; asm volatile("":"+v"(z_));
    _Pragma("unroll") for(int r=0;r<16;++r){o[0][r]=z_;o[1][r]=z_;} }
  const f32x16 negm=f32x16{};
  const int qrel=wid*QBLK+r32;
  const __attribute__((address_space(3))) char* shm3n=(const __attribute__((address_space(3))) char*)shm;
  #define CMASK(P0,P1,t) do{int jb_=(t)-(NT-4); if(jb_>=0)cmask(P0,P1,jb_,qrel,hi);}while(0)
  const __attribute__((address_space(3))) f32x4v* nfp=(const __attribute__((address_space(3))) f32x4v*)(shm3n+LDS_NF)+hi;
  #define BIAS(P0,P1,t) do{ _Pragma("unroll") for(int a_=0;a_<4;++a_){ const f32x4v b0_=nfp[16*(t)+2*a_], b1_=nfp[16*(t)+2*a_+8]; \
      _Pragma("unroll") for(int i_=0;i_<4;++i_){ P0[4*a_+i_]+=(b0_[i_]-mhat); P1[4*a_+i_]+=(b1_[i_]-mhat); } } }while(0)
  bool resc=false;
  #define START(P0,P1) do{ const float rm=rowmax(P0,P1); resc=false; \
    { const float dl=rm; mhat=fadd_s(mhat,dl); \
      _Pragma("unroll") for(int r=0;r<16;++r){P0[r]=fsub_s(P0[r],dl);P1[r]=fsub_s(P1[r],dl);} \
      } \
    _Pragma("unroll") for(int r=0;r<16;++r)P0[r]=__builtin_amdgcn_exp2f(P0[r]); }while(0)
  #define RESC() do{ if(resc){ asm volatile("s_waitcnt lgkmcnt(0)":::"memory"); \
      _Pragma("unroll") for(int d_=0;d_<2;++d_) _Pragma("unroll") for(int r=0;r<16;++r)o[d_][r]*=wsf[crow(r,hi)]; } }while(0)
  f32x16 pA0,pA1,pB0,pB1;
  int sl_prev=0,sl_cur=0,sl_next=SLOTB;
  #define ROT() do{sl_prev=sl_cur;sl_cur=sl_next;sl_next=(sl_next==(NSLOT-1)*SLOTB)?0:sl_next+SLOTB;}while(0)
  DMA_K(2,2*SLOTB);
  WAIT_BAR(3);
  qkt(pA0,pA1,Kbase,qr,negm,r32,hi);asm volatile("s_nop 15\n\ts_nop 7":"+v"(pA0),"+v"(pA1));BIAS(pA0,pA1,0);CMASK(pA0,pA1,0);
  START(pA0,pA1);
  _Pragma("unroll") for(int r=0;r<16;++r)pA1[r]=__builtin_amdgcn_exp2f(pA1[r]);
  WAIT_BAR(0);
  DMA_K(3,0);DMA_V(1,SLOTB);
  ROT();
  kload8(kf,kp0+sl_cur);
  WAIT_BAR(2);
  s16x4 vlo[8],vhi[8]; u32x4 pw0,pw1,pw2,pw3;
  #define PKW(P,B) cvtpk_s(P[B],P[B+1])
  #define PAF(k) __builtin_bit_cast(bf16x8,pw##k)
  #define VFR(i) (bf16x8){vlo[i][0],vlo[i][1],vlo[i][2],vlo[i][3],vhi[i][0],vhi[i][1],vhi[i][2],vhi[i][3]}
  #define PIN(x) asm volatile("":"+v"(x))
  #define MX3(a,b,c) __builtin_fmaxf(__builtin_fmaxf((a),(b)),(c))
  #define GAPA(MF,A0,A1,A2,A3,W0,W1,PW) do{ MF; sacc+=A0; sacc+=A1; sacc+=A2; sacc+=A3; PIN(sacc); W0; W1; PIN(PW); SBAR(); }while(0)
  #define EX(v) __builtin_amdgcn_exp2f(v)
  #define GAPB(MF,X,B) do{ MF; X[B]=EX(X[B]); X[B+1]=EX(X[B+1]); X[B+2]=EX(X[B+2]); X[B+3]=EX(X[B+3]); PIN(X); SBAR(); }while(0)
  #define VRD(i) do{ vlo[i]=vtr(vp_+(((i)>>2)*4096+((i)&3)*1024)); vhi[i]=vtr(vp_+(((i)>>2)*4096+((i)&3)*1024+512)); }while(0)
  #define KRD(G,j) do{ if(G){ kload2(kf,kp0+sl_next,j); SBAR(); } }while(0)
  #define STEP(C0,C1,P0,P1,t,GK,GV,GL) do{ SBAR(); \
    const lds_cptr vp_=vp0+sl_prev; \
    VRD(0); SBAR(); float sacc=(P0[0]+P0[1]); \
    GAPA(C0=__builtin_amdgcn_mfma_f32_32x32x16_bf16(kf[0],qr[0],negm,0,0,0), P0[2],P0[3],P0[4],P0[5],     pw0[0]=PKW(P0,0), pw0[1]=PKW(P0,2), pw0); \
    VRD(4); SBAR(); GAPA(C1=__builtin_amdgcn_mfma_f32_32x32x16_bf16(kf[1],qr[0],negm,0,0,0), P0[6],P0[7],P0[8],P0[9],     pw0[2]=PKW(P0,4), pw0[3]=PKW(P0,6), pw0); \
    VRD(1); SBAR(); GAPA(C0=__builtin_amdgcn_mfma_f32_32x32x16_bf16(kf[2],qr[1],C0,0,0,0),   P0[10],P0[11],P0[12],P0[13], pw1[0]=PKW(P0,8), pw1[1]=PKW(P0,10), pw1); \
    VRD(5); SBAR(); GAPA(C1=__builtin_amdgcn_mfma_f32_32x32x16_bf16(kf[3],qr[1],C1,0,0,0),   P0[14],P0[15],P1[0],P1[1],   pw1[2]=PKW(P0,12),pw1[3]=PKW(P0,14), pw1); \
    VRD(2); SBAR(); GAPA(C0=__builtin_amdgcn_mfma_f32_32x32x16_bf16(kf[4],qr[2],C0,0,0,0),   P1[2],P1[3],P1[4],P1[5],     pw2[0]=PKW(P1,0), pw2[1]=PKW(P1,2), pw2); \
    VRD(6); SBAR(); GAPA(C1=__builtin_amdgcn_mfma_f32_32x32x16_bf16(kf[5],qr[2],C1,0,0,0),   P1[6],P1[7],P1[8],P1[9],     pw2[2]=PKW(P1,4), pw2[3]=PKW(P1,6), pw2); \
    VRD(3); SBAR(); GAPA(C0=__builtin_amdgcn_mfma_f32_32x32x16_bf16(kf[6],qr[3],C0,0,0,0),   P1[10],P1[11],P1[12],P1[13], pw3[0]=PKW(P1,8), pw3[1]=PKW(P1,10), pw3); \
    VRD(7); SBAR(); GAPA(C1=__builtin_amdgcn_mfma_f32_32x32x16_bf16(kf[7],qr[3],C1,0,0,0),   P1[14],P1[15],0.f,0.f,       pw3[2]=PKW(P1,12),pw3[3]=PKW(P1,14), pw3); \
    l_reg+=sacc; \
    if(GK){DMA_K((t)+3,sl_cur);} if(GV){DMA_V((t)+1,sl_next);} \
    BIAS(C0,C1,t); CMASK(C0,C1,t); \
    { float a=MX3(C0[0],C0[1],C1[0]),b=MX3(C0[2],C0[3],C1[1]); a=MX3(a,C1[2],C1[3]); \
      _Pragma("unroll") for(int r=4;r<16;r+=4){a=MX3(a,C0[r],C0[r+1]);b=MX3(b,C0[r+2],C0[r+3]);a=MX3(a,C1[r],C1[r+1]);b=MX3(b,C1[r+2],C1[r+3]);} \
      float rm=__builtin_fmaxf(a,b); { auto rr=__builtin_amdgcn_permlane32_swap(__float_as_uint(rm),__float_as_uint(rm),false,false); rm=__builtin_fmaxf(__uint_as_float(rr[0]),__uint_as_float(rr[1])); } \
      resc=false; \
      if(__builtin_expect(__any(rm>(float)THRL),0)){ const float dl=__builtin_fmaxf(rm,0.f); mhat+=dl; \
        _Pragma("unroll") for(int r=0;r<16;++r){C0[r]-=dl;C1[r]-=dl;} \
        const float f=__builtin_amdgcn_exp2f(-dl); l_reg*=f; if(hi==0)wsf[r32]=f; resc=true; } } \
    SBAR(); \
    GAPB(o[0]=__builtin_amdgcn_mfma_f32_32x32x16_bf16(PAF(0),VFR(0),o[0],0,0,0), C0,0); \
    GAPB(o[1]=__builtin_amdgcn_mfma_f32_32x32x16_bf16(PAF(0),VFR(4),o[1],0,0,0), C0,4); \
    KRD(GL,0); GAPB(o[0]=__builtin_amdgcn_mfma_f32_32x32x16_bf16(PAF(1),VFR(1),o[0],0,0,0), C0,8); \
    KRD(GL,1); GAPB(o[1]=__builtin_amdgcn_mfma_f32_32x32x16_bf16(PAF(1),VFR(5),o[1],0,0,0), C0,12); \
    KRD(GL,2); GAPB(o[0]=__builtin_amdgcn_mfma_f32_32x32x16_bf16(PAF(2),VFR(2),o[0],0,0,0), C1,0); \
    KRD(GL,3); GAPB(o[1]=__builtin_amdgcn_mfma_f32_32x32x16_bf16(PAF(2),VFR(6),o[1],0,0,0), C1,4); \
    GAPB(o[0]=__builtin_amdgcn_mfma_f32_32x32x16_bf16(PAF(3),VFR(3),o[0],0,0,0), C1,8); \
    GAPB(o[1]=__builtin_amdgcn_mfma_f32_32x32x16_bf16(PAF(3),VFR(7),o[1],0,0,0), C1,12); \
    }while(0)
  int t=1;
  #undef CMASK
  #define CMASK(P0,P1,t) do{}while(0)
  for(;t+5<NT;t+=2){
    STEP(pB0,pB1,pA0,pA1,t,true,true,true);     WAIT_BAR(2); RESC(); ROT();
    STEP(pA0,pA1,pB0,pB1,t+1,true,true,true);   WAIT_BAR(2); RESC(); ROT();
  }
  #undef CMASK
  #define CMASK(P0,P1,t) do{int jb_=(t)-(NT-4); if(jb_>=0)cmask(P0,P1,jb_,qrel,hi);}while(0)
  #define ENDW(tt) do{ if((tt)+3<NT){WAIT_BAR(2);} else if((tt)+2<NT){WAIT_BAR(1);} else {WAIT_BAR(0);} }while(0)
  for(;t+1<NT;t+=2){
    STEP(pB0,pB1,pA0,pA1,t,(t+3<NT),(t+1<NT),(t+1<NT));       ENDW(t);   RESC(); ROT();
    STEP(pA0,pA1,pB0,pB1,t+1,(t+4<NT),(t+2<NT),(t+2<NT));     ENDW(t+1); RESC(); ROT();
  }
  STEP(pB0,pB1,pA0,pA1,NT-1,false,false,false); RESC();
  { float sacc=pB0[0]+pB0[1]; _Pragma("unroll") for(int r=2;r<16;++r)sacc+=pB0[r]; _Pragma("unroll") for(int r=0;r<16;++r)sacc+=pB1[r]; l_reg+=sacc;
    pw0=(u32x4){PKW(pB0,0),PKW(pB0,2),PKW(pB0,4),PKW(pB0,6)};pw1=(u32x4){PKW(pB0,8),PKW(pB0,10),PKW(pB0,12),PKW(pB0,14)};pw2=(u32x4){PKW(pB1,0),PKW(pB1,2),PKW(pB1,4),PKW(pB1,6)};pw3=(u32x4){PKW(pB1,8),PKW(pB1,10),PKW(pB1,12),PKW(pB1,14)};
    SBAR(); pv(o,vb0+sl_cur,PAF(0),PAF(1),PAF(2),PAF(3)); }
  #undef PKW
  #undef PAF
  #undef VFR
  #undef PIN
  #undef MX3
  #undef GAPA
  #undef GAPB
  #undef EX
  #undef VRD
  #undef KRD
  #undef STEP
  #undef ENDW
  {auto rr=__builtin_amdgcn_permlane32_swap(__float_as_uint(l_reg),__float_as_uint(l_reg),false,false);l_reg=__uint_as_float(rr[0])+__uint_as_float(rr[1]);}
  if(hi==0)wsf[32+r32]=l_reg;asm volatile("s_waitcnt lgkmcnt(0)":::"memory");
  float rli[16];
  #pragma unroll
  for(int r=0;r<16;++r)rli[r]=__builtin_amdgcn_rcpf(wsf[32+crow(r,hi)]);
  bf16*Ow=O+(rowbase+q0+wid*QBLK)*DM+h*D;
  { bf16*stg=(bf16*)(shm+LDS_OST)+wid*2048;
    #pragma unroll
    for(int r=0;r<16;++r){const int orow=crow(r,hi);
      #pragma unroll
      for(int d0=0;d0<2;++d0)stg[orow*64+d0*32+r32]=__float2bfloat16(o[d0][r]*rli[r]);}
    asm volatile("s_waitcnt lgkmcnt(0)":::"memory");
    #pragma unroll
    for(int i=0;i<4;++i){const int row=i*8+(lane>>3),ch=lane&7; const u32x4 v=*(const u32x4*)(stg+row*64+ch*8); ATTN_STORE16(Ow+(long)row*DM+ch*8,v);} }
  asm volatile("s_waitcnt lgkmcnt(0)\n\ts_barrier":::"memory");
  #undef BIAS
  #undef DMA_K
  #undef DMA_V
  #undef CMASK
  #undef START
  #undef RESC
  #undef ROT
}
constexpr int ATTN_LDS_BYTES=LDS_BYTES;
#undef SBAR
#undef WAIT_BAR
}
constexpr size_t MiB = 1u << 20;
constexpr size_t ACT = (size_t)MT * DMODEL * 2;
constexpr size_t WS_CTL = 0;
constexpr size_t WS_MOD = 1 * MiB, WS_MODF = 3 * MiB;
constexpr size_t WS_W13A = 4 * MiB, WS_W2A = 16 * MiB, WS_W13B = 22 * MiB, WS_W2B = 34 * MiB, WS_WIN = 40 * MiB, WS_WR = 56 * MiB, WS_WA = 58 * MiB, WS_WO = 60 * MiB, WS_RGW = 62 * MiB;
constexpr size_t WS_HN = 64 * MiB, WS_XR = WS_HN + ACT, WS_GR = WS_XR + ACT, WS_Q = WS_GR + ACT, WS_K = WS_Q + ACT, WS_V = WS_K + ACT, WS_END = WS_V + ACT;
constexpr size_t WS_G = WS_XR;
static_assert(WS_G + (size_t)MT * DFF * 2 <= WS_K && WS_END + 2 * (size_t)MT * DMODEL <= 1024 * MiB, "ws map");
constexpr int WIN_ROWS = 7424;
constexpr size_t O_Y = 0, O_KP = 67371008, O_VP = 134479872, O_LFP = 201588736, O_CVP = 202637312, O_HP = 202735616, O_KS = 202768384, O_VS = 203030528, O_LFS = 203292672, O_CVS = 203296768, O_HS = 203345920;
constexpr int RING_BYTES = 131072, LDS_BYTES = 147456;
constexpr int NWAVES = 8, NPHASE = 15;

#define LAS __attribute__((address_space(3)))
typedef unsigned short bf16;
typedef unsigned v4u __attribute__((ext_vector_type(4)));
typedef unsigned v2u __attribute__((ext_vector_type(2)));
typedef float f32x4 __attribute__((ext_vector_type(4)));
typedef short bf16x8 __attribute__((ext_vector_type(8)));
#define LDS_WAIT() asm volatile("s_waitcnt lgkmcnt(0)" ::: "memory")
__device__ __forceinline__ unsigned f2bf(float f) { unsigned u = __builtin_bit_cast(unsigned, f); return (u + 0x7fffu + ((u >> 16) & 1u)) >> 16; }
__device__ __forceinline__ unsigned pk2(float lo, float hi) { return f2bf(lo) | (f2bf(hi) << 16); }
__device__ __forceinline__ float bf2f(unsigned short h) { return __uint_as_float((unsigned)h << 16); }
__device__ __forceinline__ float wave_sum(float v) {
#pragma unroll
    for (int o = 1; o < 64; o <<= 1) v += __shfl_xor(v, o);
    return v;
}

struct Params {
    const float *x_prompt, *x_sample, *cache_k, *cache_v, *cache_logf, *state_conv, *state_rglru, *c_prompt, *c_sample, *w_ada, *b_ada;
    const float *ffn1_norm, *ffn1_w1, *ffn1_w3, *ffn1_w2, *mix_norm, *w_in, *b_fgt, *conv_w, *conv_b, *rg_wa, *rg_ba, *rg_wx, *rg_bx, *rg_lam;
    const float *w_br_rnn, *w_br_att, *w_out, *ffn2_norm, *ffn2_w1, *ffn2_w3, *ffn2_w2, *final_norm, *w_ada_f, *b_ada_f;
    float* out; unsigned char* ws; int ph_lo, ph_hi;
};

template <int MODE> __device__ __forceinline__ void p0_transpose_item(const float* W, int ldw, int nblk, bf16* WT, int ldt, int row_off, LAS float* scr, int item, int lane) {
    const int kb = item / nblk, nb = item % nblk, k0 = 64 * kb, n0 = 32 * nb;
#pragma unroll 8
    for (int i = 0; i < 32; ++i) { const int kk = 2 * i + (lane >> 5); scr[kk * 33 + (lane & 31)] = W[(size_t)(k0 + kk) * ldw + n0 + (lane & 31)]; }
    LDS_WAIT(); asm volatile("" ::: "memory");
    const int c = lane & 7;
#pragma unroll
    for (int j = 0; j < 4; ++j) { const int n = (lane >> 3) + 8 * j; const LAS float* s = scr + (8 * c) * 33 + n;
        v4u o; o.x = pk2(s[0 * 33], s[1 * 33]); o.y = pk2(s[2 * 33], s[3 * 33]); o.z = pk2(s[4 * 33], s[5 * 33]); o.w = pk2(s[6 * 33], s[7 * 33]);
        const int nn = n0 + n; const int row = (MODE == 1) ? ((nn >> 7) * 256 + (nn & 127) + row_off) : (row_off + nn);
        *(v4u*)(WT + (size_t)row * ldt + k0 + 8 * c) = o; }
    LDS_WAIT(); asm volatile("" ::: "memory");
}

__device__ __forceinline__ void p0_ada_item(const Params& P, LAS unsigned char* lds, int cgi, int wave, int lane, int tid) {
    const bool fin = cgi >= 144; const int col = fin ? (cgi - 144) * 64 + lane : cgi * 64 + lane; const int ldw = fin ? 2 * DMODEL : NMOD * DMODEL;
    const float* W = (fin ? P.w_ada_f : P.w_ada) + col;
    LAS float* sw = (LAS float*)(lds + wave * 12288);
    float acc[NBT];
#pragma unroll
    for (int b = 0; b < NBT; ++b) acc[b] = 0.f;
    for (int p = 0; p < 2; ++p) {
        const int k0 = 128 * wave + 64 * p;
#pragma unroll
        for (int b = 0; b < NBT; ++b) { const float c = (b < NB_P) ? P.c_prompt[b * DMODEL + k0 + lane] : P.c_sample[(b - NB_P) * DMODEL + k0 + lane]; sw[b * 64 + lane] = c / (1.0f + __expf(-c)); }
        LDS_WAIT(); asm volatile("" ::: "memory");
#pragma unroll 4
        for (int k4 = 0; k4 < 16; ++k4) {
            const float w0 = W[(size_t)(k0 + 4 * k4 + 0) * ldw], w1 = W[(size_t)(k0 + 4 * k4 + 1) * ldw], w2 = W[(size_t)(k0 + 4 * k4 + 2) * ldw], w3 = W[(size_t)(k0 + 4 * k4 + 3) * ldw];
#pragma unroll
            for (int b = 0; b < NBT; ++b) { const f32x4 s = *(const LAS f32x4*)(sw + b * 64 + 4 * k4); acc[b] += (s[0] * w0 + s[1] * w1) + (s[2] * w2 + s[3] * w3); }
        }
        LDS_WAIT(); asm volatile("" ::: "memory");
    }
#pragma unroll
    for (int b = 0; b < NBT; ++b) sw[b * 64 + lane] = acc[b];
    __syncthreads();
    for (int i = 0; i < 6; ++i) { const int idx = tid + 512 * i, b = idx >> 6, ln = idx & 63; float s = 0.f;
#pragma unroll
        for (int w = 0; w < 8; ++w) s += *((const LAS float*)(lds + w * 12288) + b * 64 + ln);
        const int cc = fin ? (cgi - 144) * 64 + ln : cgi * 64 + ln;
        if (fin) ((float*)(P.ws + WS_MODF))[b * (2 * DMODEL) + cc] = s + P.b_ada_f[cc];
        else ((float*)(P.ws + WS_MOD))[b * (NMOD * DMODEL) + cc] = s + P.b_ada[cc]; }
    __syncthreads();
}

__device__ __forceinline__ void p0_ada(const Params& P, LAS unsigned char* lds, int wave, int lane, int tid) {
    const int G = gridDim.x;
    for (int cgi = blockIdx.x; cgi < 176; cgi += G) p0_ada_item(P, lds, cgi, wave, lane, tid);
}
__device__ __forceinline__ void p0_prologue(const Params& P, LAS unsigned char* lds, int wave, int lane, int tid, int ilo, int ihi, int gw, int NGW) {
    const int G = gridDim.x;
    LAS float* scr = (LAS float*)(lds + wave * 16384);
    bf16* W13A = (bf16*)(P.ws + WS_W13A); bf16* W2A = (bf16*)(P.ws + WS_W2A); bf16* W13B = (bf16*)(P.ws + WS_W13B); bf16* W2B = (bf16*)(P.ws + WS_W2B);
    bf16* WIN = (bf16*)(P.ws + WS_WIN); bf16* WR = (bf16*)(P.ws + WS_WR); bf16* WA = (bf16*)(P.ws + WS_WA); bf16* WO = (bf16*)(P.ws + WS_WO); bf16* RGW = (bf16*)(P.ws + WS_RGW);
    constexpr int I_UP = 16 * 88, I_DN = 44 * 32, I_IN1 = 16 * 160, I_IN2 = 16 * 64, I_SQ = 16 * 32, I_RG = 32, I_FL = 128;
    constexpr int NITEMS = 4 * I_UP + 2 * I_DN + I_IN1 + I_IN2 + 3 * I_SQ + 2 * I_RG + I_FL;
    if (ihi > NITEMS) ihi = NITEMS;
    for (int it = ilo + gw; it < ihi; it += NGW) {
        int r = it;
        if (r < I_UP) { p0_transpose_item<1>(P.ffn1_w1, DFF, 88, W13A, DMODEL, 0, scr, r, lane); continue; } r -= I_UP;
        if (r < I_UP) { p0_transpose_item<1>(P.ffn1_w3, DFF, 88, W13A, DMODEL, 128, scr, r, lane); continue; } r -= I_UP;
        if (r < I_UP) { p0_transpose_item<1>(P.ffn2_w1, DFF, 88, W13B, DMODEL, 0, scr, r, lane); continue; } r -= I_UP;
        if (r < I_UP) { p0_transpose_item<1>(P.ffn2_w3, DFF, 88, W13B, DMODEL, 128, scr, r, lane); continue; } r -= I_UP;
        if (r < I_DN) { p0_transpose_item<0>(P.ffn1_w2, DMODEL, 32, W2A, DFF, 0, scr, r, lane); continue; } r -= I_DN;
        if (r < I_DN) { p0_transpose_item<0>(P.ffn2_w2, DMODEL, 32, W2B, DFF, 0, scr, r, lane); continue; } r -= I_DN;
        if (r < I_IN1) { p0_transpose_item<0>(P.w_in, INCOLS, 160, WIN, DMODEL, 0, scr, r, lane); continue; } r -= I_IN1;
        if (r < I_IN2) { p0_transpose_item<0>(P.w_in + 5136, INCOLS, 64, WIN, DMODEL, 5376, scr, r, lane); continue; } r -= I_IN2;
        if (r < I_SQ) { p0_transpose_item<0>(P.w_br_rnn, DMODEL, 32, WR, DMODEL, 0, scr, r, lane); continue; } r -= I_SQ;
        if (r < I_SQ) { p0_transpose_item<0>(P.w_br_att, DMODEL, 32, WA, DMODEL, 0, scr, r, lane); continue; } r -= I_SQ;
        if (r < I_SQ) { p0_transpose_item<0>(P.w_out, DMODEL, 32, WO, DMODEL, 0, scr, r, lane); continue; } r -= I_SQ;
        if (r < 2 * I_RG) { const int mat = r / I_RG, rr = r % I_RG, blk = rr >> 1, sub = rr & 1;
            p0_transpose_item<0>((mat ? P.rg_wx : P.rg_wa) + blk * 4096, 64, 2, RGW + mat * 65536 + blk * 4096, 64, 0, scr, sub, lane); continue; } r -= 2 * I_RG;
        {
#pragma unroll
            for (int h2 = 0; h2 < 2; ++h2) { const int j = 2 * r + h2; bf16* dst = WIN + (size_t)(5120 + j) * DMODEL + lane * 16;
                unsigned w[8];
#pragma unroll
                for (int q = 0; q < 8; ++q) { float a = 0.f, b = 0.f; if (j < 16) { a = P.w_in[(size_t)(lane * 16 + 2 * q) * INCOLS + 5120 + j]; b = P.w_in[(size_t)(lane * 16 + 2 * q + 1) * INCOLS + 5120 + j]; } w[q] = pk2(a, b); }
                *(v4u*)dst = (v4u){w[0], w[1], w[2], w[3]}; *(v4u*)(dst + 8) = (v4u){w[4], w[5], w[6], w[7]}; }
        }
    }
}

template <bool OUT_F32, bool IN_BF16> __device__ __forceinline__ void norm_phase(const float* srcP, const float* srcS, const bf16* srcB, const float* gvec, const float* modbase, int modstride, int jshift, int jscale,
                                                                   bf16* outb, float* outf, int wave, int lane) {
    const int gw = blockIdx.x * NWAVES + wave, NGW = gridDim.x * NWAVES;
    for (int grp = gw; grp < MT / 32; grp += NGW) {
        const int r0 = grp * 32; int bprev = -1; f32x4 gs[4], sh[4];
        for (int i = 0; i < 32; i += 4) {
            const int r = r0 + i, b = batch_of_row(r);
            if (b != bprev) { bprev = b;
#pragma unroll
                for (int j = 0; j < 4; ++j) { const int c = 4 * lane + 256 * j; const f32x4 g = *(const f32x4*)(gvec + c), sc = *(const f32x4*)(modbase + (size_t)b * modstride + jscale * DMODEL + c);
                    gs[j] = g * (sc + 1.0f); sh[j] = *(const f32x4*)(modbase + (size_t)b * modstride + jshift * DMODEL + c); } }
            f32x4 v[4][4]; float ss[4];
            if (IN_BF16) {
                v2u w[4][4];
#pragma unroll
                for (int q = 0; q < 4; ++q)
#pragma unroll
                    for (int j = 0; j < 4; ++j) w[q][j] = *(const v2u*)(srcB + (size_t)(r + q) * DMODEL + 4 * lane + 256 * j);
#pragma unroll
                for (int q = 0; q < 4; ++q)
#pragma unroll
                    for (int j = 0; j < 4; ++j) v[q][j] = (f32x4){__uint_as_float(w[q][j].x << 16), __uint_as_float(w[q][j].x & 0xffff0000u), __uint_as_float(w[q][j].y << 16), __uint_as_float(w[q][j].y & 0xffff0000u)};
            } else {
                const float* x0 = (r < MP ? srcP + (size_t)r * DMODEL : srcS + (size_t)(r - MP) * DMODEL) + 4 * lane;
#pragma unroll
                for (int q = 0; q < 4; ++q)
#pragma unroll
                    for (int j = 0; j < 4; ++j) v[q][j] = *(const f32x4*)(x0 + (size_t)q * DMODEL + 256 * j);
            }
#pragma unroll
            for (int q = 0; q < 4; ++q) { float s = 0.f;
#pragma unroll
                for (int j = 0; j < 4; ++j) s += (v[q][j][0] * v[q][j][0] + v[q][j][1] * v[q][j][1]) + (v[q][j][2] * v[q][j][2] + v[q][j][3] * v[q][j][3]);
                ss[q] = 1.0f / sqrtf(wave_sum(s) * (1.0f / DMODEL) + 1e-6f); }
#pragma unroll
            for (int q = 0; q < 4; ++q)
#pragma unroll
                for (int j = 0; j < 4; ++j) { const f32x4 a = v[q][j] * ss[q] * gs[j] + sh[j];
                    if (OUT_F32) *(f32x4*)(outf + (size_t)(r + q) * DMODEL + 4 * lane + 256 * j) = a;
                    else *(v2u*)(outb + (size_t)(r + q) * DMODEL + 4 * lane + 256 * j) = (v2u){pk2(a[0], a[1]), pk2(a[2], a[3])}; }
        }
    }
}
#define XB_TMO      128
#define XB_XCNT(j)  (256  + 64 * (j))
#define XB_XSUB(j)  (1280 + 64 * (j))
#define XB_XGEN(j)  (2304 + 64 * (j))
#define XB_TOP      3328
#define XB_TOPGEN   3392
#define XCD_BAR_WORDS 3456
#define XB_SPIN_CAP (1u << 18)

__device__ __forceinline__ unsigned xb_ld(unsigned* p)              { return __hip_atomic_load(p, __ATOMIC_RELAXED, __HIP_MEMORY_SCOPE_AGENT); }
__device__ __forceinline__ unsigned xb_add(unsigned* p, unsigned v) { return __hip_atomic_fetch_add(p, v, __ATOMIC_RELAXED, __HIP_MEMORY_SCOPE_AGENT); }
__device__ __forceinline__ unsigned xb_xcc_id() { return (unsigned)__builtin_amdgcn_s_getreg((3 << 11) | 20) & 0xFu; }
#define XB_SPIN(cond, bar) do { unsigned _sp = 0; while (cond) { __builtin_amdgcn_s_sleep(1); \
    if ((++_sp & 255u) == 0u) { if (xb_ld(&(bar)[XB_TMO])) break; if (_sp > XB_SPIN_CAP) { atomicAdd(&(bar)[XB_TMO], 1u); break; } } } } while (0)

struct XcdBarrier {
    unsigned* bar; unsigned x;
    volatile LAS unsigned* st;
};

__device__ __forceinline__ XcdBarrier xcd_barrier_post(unsigned* bar, volatile LAS unsigned* st, int tid) {
    XcdBarrier b; b.bar = bar; b.x = xb_xcc_id(); b.st = st;
    if (tid == 0) (void)xb_add(&bar[XB_XCNT(b.x)], 1u);
    return b;
}
__device__ __forceinline__ void xcd_barrier_complete(unsigned* bar, unsigned x, unsigned& nloc, unsigned& nx) {
    const unsigned G = gridDim.x * gridDim.y * gridDim.z;
    unsigned sum, cnt, mine, sp = 0u;
    for (;;) {
        sum = 0u; cnt = 0u; mine = 0u;
#pragma unroll
        for (unsigned j = 0; j < 16; ++j) { const unsigned c = xb_ld(&bar[XB_XCNT(j)]); sum += c; cnt += (c > 0u) ? 1u : 0u; mine = (j == x) ? c : mine; }
        if (sum == G) break;
        __builtin_amdgcn_s_sleep(1);
        if ((++sp & 255u) == 0u) { if (xb_ld(&bar[XB_TMO])) break; if (sp > XB_SPIN_CAP) { atomicAdd(&bar[XB_TMO], 1u); break; } }
    }
    nloc = mine > 0u ? mine : 1u; nx = cnt > 0u ? cnt : 1u;
}

__device__ __forceinline__ void xcd_barrier(const XcdBarrier& b, int tid) {
    asm volatile("s_waitcnt vmcnt(0)" ::: "memory");
    __syncthreads();
    if (tid == 0) {
        unsigned* bar = b.bar;
        __builtin_amdgcn_s_waitcnt(0);
        unsigned nloc = b.st[0], nx = b.st[1];
        if (nloc == 0u) { xcd_barrier_complete(bar, b.x, nloc, nx); b.st[0] = nloc; b.st[1] = nx; }
        const unsigned old = xb_add(&bar[XB_XSUB(b.x)], 1u);
        const unsigned gen = old / nloc;
        if (old + 1u == (gen + 1u) * nloc) {
            __builtin_amdgcn_fence(__ATOMIC_RELEASE, "agent");
            asm volatile("s_waitcnt vmcnt(0)" ::: "memory");
            const unsigned og = xb_add(&bar[XB_TOP], 1u);
            const unsigned tg = og / nx;
            if (og + 1u == (tg + 1u) * nx) xb_add(&bar[XB_TOPGEN], 1u);
            else XB_SPIN(xb_ld(&bar[XB_TOPGEN]) == tg, bar);
            __builtin_amdgcn_fence(__ATOMIC_ACQUIRE, "agent");
            xb_add(&bar[XB_XGEN(b.x)], 1u);
            asm volatile("s_waitcnt vmcnt(0)" ::: "memory");
        } else {
            XB_SPIN(xb_ld(&bar[XB_XGEN(b.x)]) == gen, bar);
            __builtin_amdgcn_fence(__ATOMIC_ACQUIRE, "agent");
            asm volatile("s_waitcnt vmcnt(0)" ::: "memory");
        }
    }
    __syncthreads();
}
namespace sg {
using pg8::bf16_t; using pg8::f32x4; using pg8::u32x4; using pg8::u32x2; using pg8::cvt_pk_bf16; using pg8::sigmoid_f; using pg8::silu_f; using pg8::gelu_tanh_f; using pg8::bf_lo; using pg8::bf_hi; using pg8::gate4; using pg8::ungate4;
__device__ __forceinline__ u32x2 pack4(f32x4 v) { u32x2 w; w.x = cvt_pk_bf16(v[0], v[1]); w.y = cvt_pk_bf16(v[2], v[3]); return w; }
struct SSwiglu { bf16_t* G; __device__ __forceinline__ void operator()(int row, int col, f32x4 a, f32x4 b) const { f32x4 v;
#pragma unroll
        for (int i = 0; i < 4; ++i) v[i] = silu_f(a[i]) * b[i];
        *(u32x2*)(G + (size_t)row * DFF + col) = pack4(v); } };
template <bool WF32> struct SResid { const float* baseS; float* out; const float* mod; int jmod; float mult; bf16_t* XB;
    __device__ __forceinline__ void operator()(int row, int col, f32x4 a, f32x4) const { const int b = batch_of_row(row);
        const f32x4 bs = *(const f32x4*)(baseS + (size_t)(row - MP) * DMODEL + col), mv = *(const f32x4*)(mod + (size_t)b * (NMOD * DMODEL) + jmod * DMODEL + col);
        const f32x4 o = bs + (mv + 1.0f) * mult * a;
        if (WF32) *(f32x4*)(out + (size_t)row * DMODEL + col) = o;
        *(u32x2*)(XB + (size_t)row * DMODEL + col) = pack4(o); } };
struct SIn { bf16_t *XR, *GR, *Q, *K, *V; float* dout; const float* bfgt; float qscale;
    __device__ __forceinline__ void operator()(int row, int col, f32x4 v, f32x4) const { const int rs = row - MP; const bool isfl = col >= 5120;
        const int reg = isfl ? 5 : (col >> 10), c = col & 1023; float* fdst = nullptr; f32x4 fv = v;
        if (isfl) { const f32x4 x = v + *(const f32x4*)(bfgt + (col - 5120));
#pragma unroll
            for (int i = 0; i < 4; ++i) fv[i] = fminf(x[i], 0.f) - log1pf(__expf(-fabsf(x[i])));
            fdst = dout + (size_t)203292672 + (size_t)rs * NHEAD + (col - 5120); }
        else if (reg == 3) fdst = dout + (size_t)202768384 + (size_t)rs * DMODEL + c;
        else if (reg == 4) fdst = dout + (size_t)203030528 + (size_t)rs * DMODEL + c;
        else if (reg == 0) { const int t = (rs & 15) - 13; if (t >= 0) fdst = dout + (size_t)203296768 + ((size_t)(rs >> 4) * 3 + t) * DMODEL + c; }
        if (fdst) *(f32x4*)fdst = fv;
        if (reg == 1) {
#pragma unroll
            for (int i = 0; i < 4; ++i) v[i] = gelu_tanh_f(v[i]); }
        if (reg == 2) v = v * qscale;
        bf16_t* dst = XR + (size_t)reg * ((size_t)MT * DMODEL);
        if (!isfl) *(u32x2*)(dst + (size_t)row * DMODEL + c) = pack4(v); } };
struct SGate { unsigned char *GA8, *GB8; __device__ __forceinline__ void operator()(int row, int col, f32x4 v, f32x4) const {
        *(unsigned*)((col < DMODEL ? GA8 : GB8) + (size_t)row * DMODEL + (col & 1023)) = gate4(v); } };
template <bool ADD> struct SZ { const unsigned char* GATE; bf16_t* Z; __device__ __forceinline__ void operator()(int row, int col, f32x4 v, f32x4) const { const size_t off = (size_t)row * DMODEL + col;
        v = v * ungate4(*(const unsigned*)(GATE + off));
        if (ADD) { const u32x2 z = *(const u32x2*)(Z + off); v[0] += bf_lo(z.x); v[1] += bf_hi(z.x); v[2] += bf_lo(z.y); v[3] += bf_hi(z.y); }
        *(u32x2*)(Z + off) = pack4(v); } };

template <bool DUAL, class SEpi> __device__ __forceinline__ void sample_gemm(const bf16_t* A, const bf16_t* Bt, int ncb, int K, const SEpi& E, int gw, int NGW, int lane) {
    const int li = lane & 15, g = lane >> 4, nsteps = K >> 5;
    for (int it = gw; it < 16 * ncb; it += NGW) {
        const int rb = it & 15, cb = it >> 4, c16 = 16 * cb;
        const bf16_t* ap = A + (size_t)(MP + 16 * rb + li) * K + 8 * g;
        const int brow = DUAL ? ((c16 >> 7) * 256 + (c16 & 127) + li) : (c16 + li);
        const bf16_t* bp = Bt + (size_t)brow * K + 8 * g; const bf16_t* bp3 = bp + (size_t)128 * K;
        f32x4 acc0 = (f32x4){0.f, 0.f, 0.f, 0.f}, acc1 = acc0;
#pragma unroll 8
        for (int s = 0; s < nsteps; ++s) { const pg8::bf16x8 a = *(const pg8::bf16x8*)(ap + 32 * s), b = *(const pg8::bf16x8*)(bp + 32 * s);
            acc0 = __builtin_amdgcn_mfma_f32_16x16x32_bf16(b, a, acc0, 0, 0, 0);
            if (DUAL) { const pg8::bf16x8 b3 = *(const pg8::bf16x8*)(bp3 + 32 * s); acc1 = __builtin_amdgcn_mfma_f32_16x16x32_bf16(b3, a, acc1, 0, 0, 0); } }
        E(MP + 16 * rb + li, c16 + 4 * g, acc0, acc1);
    }
}
}
typedef float f32x4m __attribute__((ext_vector_type(4)));
constexpr float LOG2E = 1.4426950408889634f;

__device__ __forceinline__ void forget_table(const float* lf, int stride, const float* tail, int ntail, LAS float* nf, LAS float* wtot, int tid, int lane, int wave) {
    float v0 = lf[(size_t)(4 * tid + 0) * stride], v1 = lf[(size_t)(4 * tid + 1) * stride], v2 = lf[(size_t)(4 * tid + 2) * stride], v3 = lf[(size_t)(4 * tid + 3) * stride];
    v1 += v0; v2 += v1; v3 += v2;
    float s = v3; int ln = lane; asm volatile("" : "+v"(ln));
#pragma unroll
    for (int o = 1; o < 64; o <<= 1) { const float t = __uint_as_float(__builtin_amdgcn_ds_bpermute(((ln - o) & 63) << 2, __float_as_uint(s))); if (ln >= o) s += t; }
    if (lane == 63) wtot[wave] = s;
    __syncthreads();
    float base = s - v3;
    for (int w = 0; w < wave; ++w) base += wtot[w];
    *(LAS f32x4m*)(nf + 4 * tid) = (f32x4m){-LOG2E * (base + v0), -LOG2E * (base + v1), -LOG2E * (base + v2), -LOG2E * (base + v3)};
    if (ntail > 0 && tid == 511) { float c = base + v3; for (int i = 0; i < ntail; ++i) { c += tail[i * 16]; nf[2048 + i] = -LOG2E * c; } }
    __syncthreads();
}

__device__ __forceinline__ void sattn_unit(const Params& P, int b, int h, LAS unsigned char* lds, int tid, int lane, int wave) {
    LAS float* nf = (LAS float*)lds;
    LAS float* wtot = (LAS float*)(lds + 8448);
    LAS float* PO = (LAS float*)(lds + 16384);
    LAS float* PM = (LAS float*)(lds + 16384 + 32768);
    LAS float* PL = PM + 128;
    const float* lf_new = P.out + O_LFS + (size_t)b * TS * NHEAD + h;
    forget_table(P.cache_logf + (size_t)b * PAST * NHEAD + h, NHEAD, lf_new, TS, nf, wtot, tid, lane, wave);
    const int li = lane & 15, g = lane >> 4;
    const bf16* qrow = (const bf16*)(P.ws + WS_Q) + (size_t)(MP + b * TS + li) * DMODEL + h * 64;
    float qf[4][4];
#pragma unroll
    for (int c = 0; c < 4; ++c) { const v2u w = *(const v2u*)(qrow + 16 * c + 4 * g); qf[c][0] = __uint_as_float(w.x << 16); qf[c][1] = __uint_as_float(w.x & 0xffff0000u); qf[c][2] = __uint_as_float(w.y << 16); qf[c][3] = __uint_as_float(w.y & 0xffff0000u); }
    const float* ck = P.cache_k + ((size_t)b * PAST * NHEAD + h) * 64; const float* cv = P.cache_v + ((size_t)b * PAST * NHEAD + h) * 64;
    const float* nk = P.out + O_KS + ((size_t)b * TS * NHEAD + h) * 64; const float* nv = P.out + O_VS + ((size_t)b * TS * NHEAD + h) * 64;
    float m = -INFINITY, l = 0.f; f32x4m o[4];
#pragma unroll
    for (int j = 0; j < 4; ++j) o[j] = (f32x4m){0.f, 0.f, 0.f, 0.f};
    const int nblk = (wave == 0) ? 17 : 16;
    f32x4m kf[4], vf[4], kg[4], vg[4];
#define SA_LOAD(KD, VD, IB) do { const bool nn_ = ((IB) == 16); const int k1_ = 16 * (16 * wave + (IB)); \
        const float* kb_ = nn_ ? nk : ck + (size_t)k1_ * (NHEAD * 64); const float* vb_ = nn_ ? nv : cv + (size_t)k1_ * (NHEAD * 64); \
        _Pragma("unroll") for (int c = 0; c < 4; ++c) KD[c] = *(const f32x4m*)(kb_ + (size_t)li * (NHEAD * 64) + 16 * c + 4 * g); \
        _Pragma("unroll") for (int i = 0; i < 4; ++i) VD[i] = *(const f32x4m*)(vb_ + (size_t)(4 * g + i) * (NHEAD * 64) + 4 * li); } while (0)
    SA_LOAD(kf, vf, 0); SA_LOAD(kg, vg, 1);
    for (int ib = 0; ib < nblk; ++ib) {
        const bool isnew = (ib == 16); const int key0 = isnew ? PAST : 16 * (16 * wave + ib);
        f32x4m kc[4], vc[4];
#pragma unroll
        for (int c = 0; c < 4; ++c) { kc[c] = kf[c]; vc[c] = vf[c]; kf[c] = kg[c]; vf[c] = vg[c]; }
        if (ib + 2 < nblk) SA_LOAD(kg, vg, ib + 2);
        f32x4m s = (f32x4m){0.f, 0.f, 0.f, 0.f};
#pragma unroll
        for (int c = 0; c < 4; ++c)
#pragma unroll
            for (int j = 0; j < 4; ++j) s = __builtin_amdgcn_mfma_f32_16x16x4f32(kc[c][j], qf[c][j], s, 0, 0, 0);
        const f32x4m nb = *(const LAS f32x4m*)(nf + key0 + 4 * g);
        s = s + nb;
        if (isnew) {
#pragma unroll
            for (int r = 0; r < 4; ++r) if (4 * g + r > li) s[r] = -INFINITY; }
        float bm = fmaxf(fmaxf(s[0], s[1]), fmaxf(s[2], s[3]));
        bm = fmaxf(bm, __shfl_xor(bm, 16)); bm = fmaxf(bm, __shfl_xor(bm, 32));
        const float mn = fmaxf(m, bm), alpha = __builtin_amdgcn_exp2f(m - mn);
        float p[4];
#pragma unroll
        for (int r = 0; r < 4; ++r) p[r] = __builtin_amdgcn_exp2f(s[r] - mn);
        l = l * alpha + ((p[0] + p[1]) + (p[2] + p[3])); m = mn;
#pragma unroll
        for (int r = 0; r < 4; ++r) { const float ar = __shfl(alpha, 4 * g + r);
#pragma unroll
            for (int j = 0; j < 4; ++j) o[j][r] *= ar; }
#pragma unroll
        for (int i = 0; i < 4; ++i)
#pragma unroll
            for (int j = 0; j < 4; ++j) o[j] = __builtin_amdgcn_mfma_f32_16x16x4f32(p[i], vc[i][j], o[j], 0, 0, 0);
    }
#undef SA_LOAD
    l += __shfl_xor(l, 16); l += __shfl_xor(l, 32);
    if (g == 0) { PM[wave * 16 + li] = m; PL[wave * 16 + li] = l; }
#pragma unroll
    for (int r = 0; r < 4; ++r) *(LAS f32x4m*)(PO + (wave * 16 + 4 * g + r) * 64 + 4 * li) = (f32x4m){o[0][r], o[1][r], o[2][r], o[3][r]};
    __syncthreads();
    {   const int q = tid >> 5, d = 2 * (tid & 31); float M = -INFINITY;
#pragma unroll
        for (int w = 0; w < 8; ++w) M = fmaxf(M, PM[w * 16 + q]);
        float den = 0.f, n0 = 0.f, n1 = 0.f;
#pragma unroll
        for (int w = 0; w < 8; ++w) { const float f = __builtin_amdgcn_exp2f(PM[w * 16 + q] - M); den += f * PL[w * 16 + q]; n0 += f * PO[(w * 16 + q) * 64 + d]; n1 += f * PO[(w * 16 + q) * 64 + d + 1]; }
        const float inv = 1.0f / den;
        *(unsigned*)((bf16*)(P.ws + WS_Q) + (size_t)(MP + b * TS + q) * DMODEL + h * 64 + d) = pk2(n0 * inv, n1 * inv); }
    __syncthreads();
}

__device__ __forceinline__ void rglru_item(const Params& P, int row_base, int T, int n, const float* tail0, const float* h0, float* hlast, LAS unsigned char* lds, int tid, int lane, int wave) {
    LAS float* XS = (LAS float*)lds;
    LAS float* XC = (LAS float*)(lds + 33792);
    LAS float* AA = (LAS float*)(lds + 66560);
    LAS bf16* XCB = (LAS bf16*)(lds + 99328);
    LAS float* AH = (LAS float*)(lds + 117760);
    LAS bf16* GRS = (LAS bf16*)(lds + 121856);
    const int c0 = 64 * n, li = lane & 15, g = lane >> 4;
    const bf16* XR = (const bf16*)(P.ws + WS_XR); bf16* GR = (bf16*)(P.ws + WS_GR);
    const int cc = tid & 63, tr = tid >> 6;
    const float cw0 = P.conv_w[0 * DMODEL + c0 + cc], cw1 = P.conv_w[1 * DMODEL + c0 + cc], cw2 = P.conv_w[2 * DMODEL + c0 + cc], cw3 = P.conv_w[3 * DMODEL + c0 + cc], cbv = P.conv_b[c0 + cc];
    float gba[4], gbx[4], gsp[4];
#pragma unroll
    for (int ct = 0; ct < 4; ++ct) { const int c = c0 + 16 * ct + li; gba[ct] = P.rg_ba[c]; gbx[ct] = P.rg_bx[c]; const float lam = P.rg_lam[c];
        const float sp = (lam < -15.f) ? -lam : log1pf(__expf(-lam)); gsp[ct] = -8.0f * sp; }
    bf16x8 wfa[4][2], wfx[4][2];
    { const bf16* RGW = (const bf16*)(P.ws + WS_RGW) + n * 4096;
#pragma unroll
      for (int ct = 0; ct < 4; ++ct)
#pragma unroll
        for (int s = 0; s < 2; ++s) { wfa[ct][s] = *(const bf16x8*)(RGW + (16 * ct + li) * 64 + 32 * s + 8 * g); wfx[ct][s] = *(const bf16x8*)(RGW + 65536 + (16 * ct + li) * 64 + 32 * s + 8 * g); } }
    float hc = h0 ? h0[c0 + lane] : 0.f;
    const int nchunk = (T + 127) / 128;
    const int prow0 = tid >> 3, pc8 = (tid & 7) * 8;
    v4u xpre[2], gpre[2];
#pragma unroll
    for (int i = 0; i < 2; ++i) { const int row = prow0 + 64 * i; xpre[i] = (v4u){0u, 0u, 0u, 0u}; gpre[i] = xpre[i];
        if (row < T) { const size_t o = (size_t)(row_base + row) * DMODEL + c0 + pc8; xpre[i] = *(const v4u*)(XR + o); gpre[i] = *(const v4u*)(GR + o); } }
    for (int ch = 0; ch < nchunk; ++ch) {
        const int t0 = ch * 128, nvalid = (T - t0) < 128 ? (T - t0) : 128;
        float tv = 0.f;
        if (tid < 192) { if (ch == 0) tv = tail0 ? tail0[(size_t)(tid >> 6) * DMODEL + c0 + (tid & 63)] : 0.f; else tv = XS[(128 + (tid >> 6)) * 64 + (tid & 63)]; }
        __syncthreads();
        if (tid < 192) XS[(tid >> 6) * 64 + (tid & 63)] = tv;
#pragma unroll
        for (int i = 0; i < 2; ++i) { const int row = prow0 + 64 * i; const v4u w = xpre[i];
            LAS float* d = XS + (3 + row) * 64 + pc8;
            *(LAS f32x4m*)d = (f32x4m){__uint_as_float(w.x << 16), __uint_as_float(w.x & 0xffff0000u), __uint_as_float(w.y << 16), __uint_as_float(w.y & 0xffff0000u)};
            *(LAS f32x4m*)(d + 4) = (f32x4m){__uint_as_float(w.z << 16), __uint_as_float(w.z & 0xffff0000u), __uint_as_float(w.w << 16), __uint_as_float(w.w & 0xffff0000u)};
            *(LAS v4u*)(GRS + row * 64 + pc8) = gpre[i]; }
        if (ch + 1 < nchunk) {
#pragma unroll
            for (int i = 0; i < 2; ++i) { const int row = t0 + 128 + prow0 + 64 * i; xpre[i] = (v4u){0u, 0u, 0u, 0u}; gpre[i] = xpre[i];
                if (row < T) { const size_t o = (size_t)(row_base + row) * DMODEL + c0 + pc8; xpre[i] = *(const v4u*)(XR + o); gpre[i] = *(const v4u*)(GR + o); } } }
        __syncthreads();
#pragma unroll 4
        for (int i = 0; i < 16; ++i) { const int t = 16 * tr + i;
            const float y = cbv + (cw0 * XS[t * 64 + cc] + cw1 * XS[(t + 1) * 64 + cc]) + (cw2 * XS[(t + 2) * 64 + cc] + cw3 * XS[(t + 3) * 64 + cc]);
            XC[t * 64 + cc] = y; XCB[t * 72 + cc] = (bf16)f2bf(y); }
        { bf16x8 af[2];
#pragma unroll
          for (int s = 0; s < 2; ++s) af[s] = *(const LAS bf16x8*)(XCB + (16 * wave + li) * 72 + 32 * s + 8 * g);
#pragma unroll
          for (int ct = 0; ct < 4; ++ct) { f32x4m pa = (f32x4m){0.f, 0.f, 0.f, 0.f}, px = pa;
#pragma unroll
            for (int s = 0; s < 2; ++s) { pa = __builtin_amdgcn_mfma_f32_16x16x32_bf16(af[s], wfa[ct][s], pa, 0, 0, 0); px = __builtin_amdgcn_mfma_f32_16x16x32_bf16(af[s], wfx[ct][s], px, 0, 0, 0); }
#pragma unroll
            for (int r = 0; r < 4; ++r) { const int t = 16 * wave + 4 * g + r, c = 16 * ct + li;
                const float rr = pg8::sigmoid_f(pa[r] + gba[ct]), ii = pg8::sigmoid_f(px[r] + gbx[ct]);
                const float la = gsp[ct] * rr, a = __expf(la);
                const float om = (1.0f - a) * (1.0f + a);
                const float u = sqrtf(om) * ii * XC[t * 64 + c];
                AA[t * 64 + c] = a; XC[t * 64 + c] = u; } } }
        { float A = 1.f, H = 0.f;
#pragma unroll
          for (int tt = 0; tt < 16; ++tt) { const float a = AA[(16 * wave + tt) * 64 + lane], u = XC[(16 * wave + tt) * 64 + lane]; H = a * H + u; A *= a; }
          AH[(wave * 2 + 0) * 64 + lane] = A; AH[(wave * 2 + 1) * 64 + lane] = H; }
        __syncthreads();
        { const int nvw = nvalid >> 4; float hin = hc, hend = hc;
#pragma unroll
          for (int w = 0; w < 8; ++w) { const float A = AH[(w * 2) * 64 + lane], H = AH[(w * 2 + 1) * 64 + lane]; if (w < wave) hin = A * hin + H; if (w < nvw) hend = A * hend + H; }
          if (wave < nvw) { float h = hin;
#pragma unroll
            for (int tt = 0; tt < 16; ++tt) { const int t = 16 * wave + tt; const float a = AA[t * 64 + lane], u = XC[t * 64 + lane]; h = a * h + u;
                GRS[t * 64 + lane] = (bf16)f2bf(h * bf2f(GRS[t * 64 + lane])); } }
          if (wave < nvw) { const int row = 16 * wave + (lane >> 2), cp = (lane & 3) * 16;
#pragma unroll
            for (int i = 0; i < 2; ++i) *(v4u*)(GR + (size_t)(row_base + t0 + row) * DMODEL + c0 + cp + 8 * i) = *(const LAS v4u*)(GRS + row * 64 + cp + 8 * i); }
          hc = hend; }
    }
    if (wave == 0) hlast[c0 + lane] = hc;
    __syncthreads();
}
#ifndef MK_SPLIT
#define MK_SPLIT 0
#endif
__global__ void __launch_bounds__(NWAVES * 64, 2) fwd_megakernel(Params P) {
    extern __shared__ __attribute__((aligned(16))) unsigned char lds_raw[];
    LAS unsigned char* lds = (LAS unsigned char*)lds_raw;
    const int G = gridDim.x;
    const int wave0 = __builtin_amdgcn_readfirstlane(threadIdx.x >> 6);
#define TID_DEFS int tid_; asm volatile("v_mbcnt_lo_u32_b32 %0, -1, 0\n\tv_mbcnt_hi_u32_b32 %0, -1, %0" : "=v"(tid_)); tid_ += wave0 * 64; const int tid = tid_, lane = tid & 63, wave = __builtin_amdgcn_readfirstlane(tid >> 6); (void)lane; (void)wave
    cg::grid_group grid = cg::this_grid();
    unsigned char* ws = P.ws;
    bf16* HN = (bf16*)(ws + WS_HN); bf16* XR = (bf16*)(ws + WS_XR); bf16* GR = (bf16*)(ws + WS_GR); bf16* QB = (bf16*)(ws + WS_Q); bf16* KB = (bf16*)(ws + WS_K); bf16* VB = (bf16*)(ws + WS_V); bf16* GB = (bf16*)(ws + WS_G);
    const float* MOD = (const float*)(ws + WS_MOD); const float* MODF = (const float*)(ws + WS_MODF);
    unsigned char* GA8 = ws + WS_END; unsigned char* GB8 = ws + WS_END + (size_t)MT * DMODEL;
    float* X = P.out + O_Y;
#ifdef PH_ONLY
#define IN(k) ((k) == PH_ONLY)
#else
#define IN(k) (P.ph_lo <= (k) && (k) < P.ph_hi)
#endif
#define STAMP(k) do {} while (0)
#define SEAM(k) do { if (IN(k) && IN((k) + 1)) { { TID_DEFS; xcd_barrier(bar, tid); } } STAMP(k); } while (0)
    if (P.ph_lo < 0) grid.sync();
    XcdBarrier bar;
    { TID_DEFS; for (int u = tid; u < 64; u += NWAVES * 64) ((LAS unsigned*)(lds + LDS_BYTES - 256))[u] = 0u; __syncthreads();
      bar = xcd_barrier_post((unsigned*)(ws + WS_CTL), (volatile LAS unsigned*)(lds + LDS_BYTES - 256) + 8, tid); }
#define GEMM_PHASE(EPI, e, Aptr, Bptr, NN, KK) do { pg8::Gemm g_{(const pg8::bf16_t*)(Aptr), (const pg8::bf16_t*)(Bptr), MP, (NN), (KK)}; pg8::StaticOrder S_; S_.init(MP, (NN), G, (int)blockIdx.x); \
        TID_DEFS; pg8::gemm_phase<EPI, pg8::StaticOrder, true, true>(lds, g_, S_, e, tid); } while (0)

#define SAMPLE_GEMM(DUAL, se, Aptr, Bptr, NCB, KK) do { TID_DEFS; sg::sample_gemm<DUAL>((const pg8::bf16_t*)(Aptr), (const pg8::bf16_t*)(Bptr), (NCB), (KK), se, (int)blockIdx.x * NWAVES + wave, G * NWAVES, lane); } while (0)
    constexpr int P0_SPLIT = 5632;
    if (IN(0)) { TID_DEFS; p0_ada(P, lds, wave, lane, tid); if ((int)blockIdx.x >= 176 && G > 176) p0_prologue(P, lds, wave, lane, tid, 0, P0_SPLIT, ((int)blockIdx.x - 176) * NWAVES + wave, (G - 176) * NWAVES); } SEAM(0);
    if (IN(1)) { TID_DEFS; p0_prologue(P, lds, wave, lane, tid, (G > 176) ? P0_SPLIT : 0, 1 << 30, (int)blockIdx.x * NWAVES + wave, G * NWAVES); norm_phase<false, false>(P.x_prompt, P.x_sample, nullptr, P.ffn1_norm, MOD, NMOD * DMODEL, 0, 1, HN, nullptr, wave, lane); } SEAM(1);
    if (IN(2)) { pg8::EpiSwiglu e{GB}; GEMM_PHASE(pg8::EpiSwiglu, e, HN, ws + WS_W13A, 2 * DFF, DMODEL); sg::SSwiglu se{GB}; SAMPLE_GEMM(true, se, HN, ws + WS_W13A, DFF / 16, DMODEL); } SEAM(2);
    if (IN(3)) { pg8::EpiResid<true> e{P.x_prompt, X, MOD, 2, 0.5f, HN}; GEMM_PHASE(pg8::EpiResid<true>, e, GB, ws + WS_W2A, DMODEL, DFF); sg::SResid<true> se{P.x_sample, X, MOD, 2, 0.5f, HN}; SAMPLE_GEMM(false, se, GB, ws + WS_W2A, DMODEL / 16, DFF); } SEAM(3);
    if (IN(4)) { TID_DEFS; norm_phase<false, true>(nullptr, nullptr, HN, P.mix_norm, MOD, NMOD * DMODEL, 3, 4, HN, nullptr, wave, lane); } SEAM(4);
    if (IN(5)) { pg8::EpiIn e{XR, GR, QB, KB, VB, P.out, P.b_fgt, attn_body::C2, GA8, GB8}; GEMM_PHASE(pg8::EpiIn, e, HN, ws + WS_WIN, 29 * 256, DMODEL); sg::SIn se{XR, GR, QB, KB, VB, P.out, P.b_fgt, attn_body::C2}; SAMPLE_GEMM(false, se, HN, ws + WS_WIN, 5136 / 16, DMODEL);
        sg::SGate sgt{GA8, GB8}; SAMPLE_GEMM(false, sgt, HN, ws + WS_WIN + (size_t)5376 * DMODEL * 2, 2048 / 16, DMODEL); } SEAM(5);

    if (IN(6)) {
#ifndef NO_ATTN
        for (int bh = blockIdx.x; bh < NB_P * NHEAD; bh += G) { TID_DEFS; const int b = bh >> 4, h = bh & 15;
            forget_table(P.out + O_LFP + (size_t)b * SEQ_P * NHEAD + h, NHEAD, nullptr, 0, (LAS float*)(lds + attn_body::LDS_NF), (LAS float*)(lds + attn_body::LDS_NFW), tid, lane, wave);
            for (int qb = 7; qb >= 0; --qb) attn_body::attn_unit<16>(b, h, qb, (const attn_body::bf16*)QB, (const attn_body::bf16*)KB, (const attn_body::bf16*)VB, (attn_body::bf16*)QB, (char*)lds_raw, tid);
            __syncthreads(); }
#endif
#ifndef NO_SATTN
        for (int u = blockIdx.x; u < NB_S * NHEAD; u += G) { TID_DEFS; sattn_unit(P, u >> 4, u & 15, lds, tid, lane, wave); }
#endif
#ifndef NO_RGLRU
        for (int it = blockIdx.x; it < NB_P * 16; it += G) { TID_DEFS; const int b = it >> 4, n = it & 15; rglru_item(P, b * SEQ_P, SEQ_P, n, nullptr, nullptr, P.out + O_HP + (size_t)b * DMODEL, lds, tid, lane, wave); }
        for (int it = blockIdx.x; it < NB_S * 16; it += G) { TID_DEFS; const int b = it >> 4, n = it & 15;
            rglru_item(P, MP + b * TS, TS, n, P.state_conv + (size_t)b * 3 * DMODEL, P.state_rglru + (size_t)b * DMODEL, P.out + O_HS + (size_t)b * DMODEL, lds, tid, lane, wave); }
#endif
    } SEAM(6);

    if (IN(8)) { pg8::EpiZ<false> e{GA8, VB}; GEMM_PHASE(pg8::EpiZ<false>, e, GR, ws + WS_WR, DMODEL, DMODEL); sg::SZ<false> se{GA8, VB}; SAMPLE_GEMM(false, se, GR, ws + WS_WR, DMODEL / 16, DMODEL); }
    if (IN(9)) { pg8::EpiZ<true> e{GB8, VB}; GEMM_PHASE(pg8::EpiZ<true>, e, QB, ws + WS_WA, DMODEL, DMODEL); sg::SZ<true> se{GB8, VB}; SAMPLE_GEMM(false, se, QB, ws + WS_WA, DMODEL / 16, DMODEL); } SEAM(9);
    if (IN(10)) { pg8::EpiResid<true> e{X, X, MOD, 5, 1.0f, HN}; GEMM_PHASE(pg8::EpiResid<true>, e, VB, ws + WS_WO, DMODEL, DMODEL); sg::SResid<true> se{X + (size_t)MP * DMODEL, X, MOD, 5, 1.0f, HN}; SAMPLE_GEMM(false, se, VB, ws + WS_WO, DMODEL / 16, DMODEL); } SEAM(10);
    if (IN(11)) { TID_DEFS; norm_phase<false, true>(nullptr, nullptr, HN, P.ffn2_norm, MOD, NMOD * DMODEL, 6, 7, HN, nullptr, wave, lane); } SEAM(11);
    if (IN(12)) { pg8::EpiSwiglu e{GB}; GEMM_PHASE(pg8::EpiSwiglu, e, HN, ws + WS_W13B, 2 * DFF, DMODEL); sg::SSwiglu se{GB}; SAMPLE_GEMM(true, se, HN, ws + WS_W13B, DFF / 16, DMODEL); } SEAM(12);
    if (IN(13)) { pg8::EpiResid<false> e{X, X, MOD, 8, 0.5f, HN}; GEMM_PHASE(pg8::EpiResid<false>, e, GB, ws + WS_W2B, DMODEL, DFF); sg::SResid<false> se{X + (size_t)MP * DMODEL, X, MOD, 8, 0.5f, HN}; SAMPLE_GEMM(false, se, GB, ws + WS_W2B, DMODEL / 16, DFF); } SEAM(13);
    if (IN(14)) { TID_DEFS; norm_phase<true, true>(nullptr, nullptr, HN, P.final_norm, MODF, 2 * DMODEL, 0, 1, nullptr, X, wave, lane); }

#undef IN
#undef SEAM
#undef GEMM_PHASE
#undef SAMPLE_GEMM
}

extern "C" void kernel_launch(void* const* d_in, const int* in_sizes, int n_in, void* d_out, int out_size, void* d_ws, size_t ws_size, hipStream_t stream) {
    static int grid = 0;
    if (grid == 0) {
        if (n_in != 35 || ws_size < WS_END) { fprintf(stderr, "kernel_launch: unexpected n_in %d / ws %zu\n", n_in, ws_size); grid = -1; return; }
        int dev = 0, cus = 0, per_cu = 0;
        hipGetDevice(&dev); hipDeviceGetAttribute(&cus, hipDeviceAttributeMultiprocessorCount, dev);
        if (hipFuncSetAttribute((const void*)fwd_megakernel, hipFuncAttributeMaxDynamicSharedMemorySize, LDS_BYTES) != hipSuccess) { fprintf(stderr, "kernel_launch: hipFuncSetAttribute failed\n"); grid = -1; return; }
        if (hipOccupancyMaxActiveBlocksPerMultiprocessor(&per_cu, (const void*)fwd_megakernel, NWAVES * 64, LDS_BYTES) != hipSuccess || per_cu < 1) { fprintf(stderr, "kernel_launch: occupancy query says %d\n", per_cu); per_cu = 1; }
        (void)hipGetLastError();
        grid = cus;
    }
    if (grid < 0) return;
    if (hipMemsetAsync((char*)d_ws + WS_CTL, 0, 65536, stream) != hipSuccess) { fprintf(stderr, "kernel_launch: memset failed\n"); return; }
    Params p{};
    const float** pp = (const float**)&p;
    for (int i = 0; i < 35; ++i) pp[i] = (const float*)d_in[i];
    p.out = (float*)d_out; p.ws = (unsigned char*)d_ws;
#if MK_SPLIT
    for (int ph = 0; ph < NPHASE; ++ph) { p.ph_lo = ph; p.ph_hi = ph + 1; void* args[] = {&p};
        hipError_t e = hipLaunchCooperativeKernel((const void*)fwd_megakernel, dim3(grid), dim3(NWAVES * 64), args, LDS_BYTES, stream);
        if (e != hipSuccess) { fprintf(stderr, "cooperative launch (phase %d) failed: %s\n", ph, hipGetErrorString(e)); break; } }
#else
    p.ph_lo = 0; p.ph_hi = NPHASE; void* args[] = {&p};
    hipError_t e = hipLaunchCooperativeKernel((const void*)fwd_megakernel, dim3(grid), dim3(NWAVES * 64), args, LDS_BYTES, stream);
    if (e != hipSuccess) fprintf(stderr, "cooperative launch failed: %s (grid %d)\n", hipGetErrorString(e), grid);
#endif
}
```

```cpp
#include <hip/hip_runtime.h>
#include <hip/hip_cooperative_groups.h>
#include <hip/hip_bf16.h>
#include <cstdio>
#include <cstdint>
#include <cmath>
namespace cg = cooperative_groups;

constexpr int DMODEL = 1024, MP = 65536, MS = 256, MT = MP + MS, SEQ_P = 2048, NB_P = 32, NB_S = 16, TS = 16, PAST = 2048;
constexpr int DFF = 2816, NHEAD = 16, NMOD = 9, INCOLS = 7184;
constexpr int NBT = NB_P + NB_S;
__device__ __forceinline__ int batch_of_row(int r) { return r < MP ? (r >> 11) : NB_P + ((r - MP) >> 4); }

namespace pg8 {
#define PG8_LAS __attribute__((address_space(3)))
typedef unsigned short bf16_t;
typedef short bf16x8 __attribute__((ext_vector_type(8)));
typedef float f32x4 __attribute__((ext_vector_type(4)));
typedef unsigned u32x4 __attribute__((ext_vector_type(4)));
typedef unsigned u32x2 __attribute__((ext_vector_type(2)));
constexpr int BM = 256, BK = 64, HALF = 128, HTB = HALF * BK * 2  , STAGE_BYTES = 8 * HTB, NXCD = 8, WGM = 4;

__host__ __device__ __forceinline__ int lds_byte(int r, int c) { const int st = (r >> 4) * 2 + (c >> 5), rr = r & 15, cc = c & 31, ob = rr * 64 + cc * 2; return st * 1024 + (ob ^ (((ob >> 9) & 1) << 5)); }
__host__ __device__ __forceinline__ void stage_rc(int b, int& R, int& C) { const int st = b / 1024, sb = b % 1024, swz = sb ^ (((sb >> 9) & 1) << 5); R = (st >> 1) * 16 + swz / 64; C = (st & 1) * 32 + (swz % 64) / 2; }
__host__ __device__ __forceinline__ int perm32(int rho) { const int n = rho >> 4, i = rho & 15; return 8 * (i >> 2) + 4 * n + (i & 3); }

struct Unit { int pm, pn; };
struct Gemm { const bf16_t* A; const bf16_t* Bt; int M, N, K; };

struct StaticOrder {
    int nM, nN, nwg, G, c;
    __host__ __device__ void init(int M, int N, int G_, int c_) { nM = M / BM; nN = N / BM; nwg = nM * nN; G = G_; c = c_; }
    __host__ __device__ bool next(int i, Unit& u) const {
        const long L = (long)i * G + c; if (L >= nwg) return false;
        int wgid = (int)L; { const int q = nwg / NXCD, r = nwg % NXCD, xcd = wgid % NXCD, off = wgid / NXCD; wgid = (xcd < r ? xcd * (q + 1) : r * (q + 1) + (xcd - r) * q) + off; }
        const int nig = WGM * nN, gid = wgid / nig, fm = gid * WGM, gsz = (nM - fm) < WGM ? (nM - fm) : WGM;
        u.pm = fm + ((wgid % nig) % gsz); u.pn = (wgid % nig) / gsz; return true;
    }
    __device__ __forceinline__ void a_ready(const Unit&) const {}
    __device__ __forceinline__ void done(const Unit&) const {}
};

typedef float f32x2c_t __attribute__((ext_vector_type(2))); typedef __bf16 bf16x2c_t __attribute__((ext_vector_type(2)));
__device__ __forceinline__ unsigned cvt_pk_bf16(float lo, float hi) { const f32x2c_t v = {lo, hi}; const bf16x2c_t b = __builtin_convertvector(v, bf16x2c_t); return __builtin_bit_cast(unsigned, b); }
__device__ __forceinline__ float bf_lo(unsigned w) { return __uint_as_float(w << 16); }
__device__ __forceinline__ float bf_hi(unsigned w) { return __uint_as_float(w & 0xffff0000u); }
__device__ __forceinline__ float sigmoid_f(float x) { return __builtin_amdgcn_rcpf(1.0f + __builtin_amdgcn_exp2f(-1.4426950408889634f * x)); }
__device__ __forceinline__ float silu_f(float x) { return x * sigmoid_f(x); }
__device__ __forceinline__ float gelu_tanh_f(float x) { const float y = 1.5957691216057308f * (x + 0.044715f * x * x * x); return x * sigmoid_f(y); }
__device__ __forceinline__ u32x4 pack8(f32x4 a, f32x4 b) { u32x4 w; w.x = cvt_pk_bf16(a[0], a[1]); w.y = cvt_pk_bf16(a[2], a[3]); w.z = cvt_pk_bf16(b[0], b[1]); w.w = cvt_pk_bf16(b[2], b[3]); return w; }
__device__ __forceinline__ int epi_batch(const Unit& u, int ai, int wr, int m) { return u.pm < 256 ? (u.pm >> 3) : NB_P + 8 * ai + 4 * wr + m; }

__device__ __forceinline__ unsigned gate4(f32x4 v) { unsigned w = 0;
#pragma unroll
    for (int i = 0; i < 4; ++i) w |= (unsigned)(sigmoid_f(v[i]) * 255.0f + 0.5f) << (8 * i);
    return w; }
__device__ __forceinline__ f32x4 ungate4(unsigned w) { return (f32x4){(float)(w & 255u), (float)((w >> 8) & 255u), (float)((w >> 16) & 255u), (float)(w >> 24)} * (1.0f / 255.0f); }
struct EpiSwiglu {
    static constexpr bool PERM = true, AFTER_DRAIN = false;
    bf16_t* G;
    __device__ __forceinline__ void operator()(const f32x4 (&acc)[2][2][4][2], const Unit& u, int wr, int wc, int fr, int fq) const {
        const int row0 = u.pm * BM + wr * 64 + fr, col0 = u.pn * HALF + wc * 32 + 8 * fq;
#pragma unroll
        for (int ai = 0; ai < 2; ++ai)
#pragma unroll
            for (int m = 0; m < 4; ++m) { bf16_t* rowp = G + (size_t)(row0 + ai * HALF + m * 16) * DFF + col0;
                const f32x4 a0 = acc[ai][0][m][0], a1 = acc[ai][0][m][1], b0 = acc[ai][1][m][0], b1 = acc[ai][1][m][1];
                f32x4 v0, v1;
#pragma unroll
                for (int i = 0; i < 4; ++i) { v0[i] = silu_f(a0[i]) * b0[i]; v1[i] = silu_f(a1[i]) * b1[i]; }
                *(u32x4*)rowp = pack8(v0, v1); }
    }
};

template <bool WF32> struct EpiResid {
    static constexpr bool PERM = true, AFTER_DRAIN = false;
    const float* base; float* out; const float* mod; int jmod; float mult; bf16_t* XB;
    __device__ __forceinline__ void operator()(const f32x4 (&acc)[2][2][4][2], const Unit& u, int wr, int wc, int fr, int fq) const {
        const int col0 = u.pn * BM + wc * 32 + 8 * fq; const float* mp = mod + (size_t)(u.pm >> 3) * (NMOD * DMODEL) + jmod * DMODEL + col0;
#pragma unroll
        for (int ai = 0; ai < 2; ++ai)
#pragma unroll
            for (int m = 0; m < 4; ++m) { const size_t ro = (size_t)(u.pm * BM + ai * HALF + wr * 64 + m * 16 + fr) * DMODEL + col0;
#pragma unroll
                for (int bj = 0; bj < 2; ++bj) { const int o = bj * HALF;
                    const f32x4 o0 = *(const f32x4*)(base + ro + o) + (*(const f32x4*)(mp + o) + 1.0f) * mult * acc[ai][bj][m][0];
                    const f32x4 o1 = *(const f32x4*)(base + ro + o + 4) + (*(const f32x4*)(mp + o + 4) + 1.0f) * mult * acc[ai][bj][m][1];
                    if (WF32) { *(f32x4*)(out + ro + o) = o0; *(f32x4*)(out + ro + o + 4) = o1; }
                    *(u32x4*)(XB + ro + o) = pack8(o0, o1); } }
    }
};

struct EpiIn {
    static constexpr bool PERM = true, AFTER_DRAIN = false;
    bf16_t *XR, *GR, *Q, *K, *V; float* dout; const float* bfgt; float qscale; unsigned char *GA8, *GB8;
    __device__ __forceinline__ void operator()(const f32x4 (&acc)[2][2][4][2], const Unit& u, int wr, int wc, int fr, int fq) const {
        if (u.pn >= 21) {
            const int gi = u.pn - 21; unsigned char* dst = (gi < 4) ? GA8 : GB8; const int c0 = (gi & 3) * BM + wc * 32 + 8 * fq;
#pragma unroll
            for (int ai = 0; ai < 2; ++ai)
#pragma unroll
                for (int m = 0; m < 4; ++m) { unsigned char* rowp = dst + (size_t)(u.pm * BM + ai * HALF + wr * 64 + m * 16 + fr) * DMODEL + c0;
#pragma unroll
                    for (int bj = 0; bj < 2; ++bj) *(u32x2*)(rowp + bj * HALF) = (u32x2){gate4(acc[ai][bj][m][0]), gate4(acc[ai][bj][m][1])}; }
            return; }
        const int reg = u.pn >> 2, colt = (u.pn & 3) * BM, col0 = colt + wc * 32 + 8 * fq;
        if (u.pn == 20) {
            if (wc == 0 && fq < 2) {
#pragma unroll
                for (int ai = 0; ai < 2; ++ai)
#pragma unroll
                    for (int m = 0; m < 4; ++m) { const int row = u.pm * BM + ai * HALF + wr * 64 + m * 16 + fr;
                        float* lp = dout + (row < MP ? (size_t)201588736 + (size_t)row * NHEAD : (size_t)203292672 + (size_t)(row - MP) * NHEAD) + 8 * fq;
#pragma unroll
                        for (int n = 0; n < 2; ++n) { f32x4 x = acc[ai][0][m][n] + *(const f32x4*)(bfgt + 8 * fq + 4 * n), o;
#pragma unroll
                            for (int i = 0; i < 4; ++i) o[i] = fminf(x[i], 0.f) - log1pf(__expf(-fabsf(x[i])));
                            *(f32x4*)(lp + 4 * n) = o; } }
            }
            return;
        }
        bf16_t* dst = reg == 0 ? XR : reg == 1 ? GR : reg == 2 ? Q : reg == 3 ? K : V;
#pragma unroll
        for (int ai = 0; ai < 2; ++ai)
#pragma unroll
            for (int m = 0; m < 4; ++m) { const int row = u.pm * BM + ai * HALF + wr * 64 + m * 16 + fr; bf16_t* rowp = dst + (size_t)row * DMODEL + col0;
#pragma unroll
                for (int bj = 0; bj < 2; ++bj) { f32x4 v0 = acc[ai][bj][m][0], v1 = acc[ai][bj][m][1];
                    if (reg == 1) {
#pragma unroll
                        for (int i = 0; i < 4; ++i) { v0[i] = gelu_tanh_f(v0[i]); v1[i] = gelu_tanh_f(v1[i]); } }
                    else if (reg == 2) { v0 = v0 * qscale; v1 = v1 * qscale; }
                    else if (reg >= 3) {
                        float* op = dout + (reg == 3 ? (row < MP ? (size_t)67371008 : (size_t)202768384) : (row < MP ? (size_t)134479872 : (size_t)203030528))
                                    + (size_t)(row < MP ? row : row - MP) * DMODEL + col0 + bj * HALF;
                        *(f32x4*)op = v0; *(f32x4*)(op + 4) = v1; }
                    else {
                        int t, b; if (row < MP) { t = (row & 2047) - 2045; b = row >> 11; } else { t = ((row - MP) & 15) - 13; b = (row - MP) >> 4; }
                        if (t >= 0) { float* op = dout + (row < MP ? (size_t)202637312 : (size_t)203296768) + ((size_t)b * 3 + t) * DMODEL + col0 + bj * HALF;
                            *(f32x4*)op = v0; *(f32x4*)(op + 4) = v1; } }
                    *(u32x4*)(rowp + bj * HALF) = pack8(v0, v1); } }
    }
};

template <bool ADD> struct EpiZ {
    static constexpr bool PERM = true, AFTER_DRAIN = false;
    const unsigned char* GATE; bf16_t* Z;
    __device__ __forceinline__ void operator()(const f32x4 (&acc)[2][2][4][2], const Unit& u, int wr, int wc, int fr, int fq) const {
        const int col0 = u.pn * BM + wc * 32 + 8 * fq;
#pragma unroll
        for (int ai = 0; ai < 2; ++ai)
#pragma unroll
            for (int m = 0; m < 4; ++m) { const int row = u.pm * BM + ai * HALF + wr * 64 + m * 16 + fr; const size_t off = (size_t)row * DMODEL + col0;
#pragma unroll
                for (int bj = 0; bj < 2; ++bj) { const u32x2 g = *(const u32x2*)(GATE + off + bj * HALF); f32x4 v0 = acc[ai][bj][m][0] * ungate4(g.x), v1 = acc[ai][bj][m][1] * ungate4(g.y);
                    if (ADD) { const u32x4 z = *(const u32x4*)(Z + off + bj * HALF);
                        v0[0] += bf_lo(z.x); v0[1] += bf_hi(z.x); v0[2] += bf_lo(z.y); v0[3] += bf_hi(z.y); v1[0] += bf_lo(z.z); v1[1] += bf_hi(z.z); v1[2] += bf_lo(z.w); v1[3] += bf_hi(z.w); }
                    *(u32x4*)(Z + off + bj * HALF) = pack8(v0, v1); } }
    }
};

template <class Epi, class Sched, bool ALIGN_EPI = false, bool SP2 = false>
__device__ __forceinline__ void gemm_phase(PG8_LAS unsigned char* lds, const Gemm g, const Sched& S, const Epi& E, const int tid) {
    const int wid = __builtin_amdgcn_readfirstlane(tid >> 6), lane = tid & 63, wr = wid >> 2, wc = wid & 3, fr = lane & 15, fq = lane >> 4;
    const int K = g.K, nt = K / BK;
    unsigned voffA[2], voffB[2];
#pragma unroll
    for (int i = 0; i < 2; ++i) { int R, C; stage_rc(tid * 16 + i * 8192, R, C); const int Rb = Epi::PERM ? ((R & ~31) + perm32(R & 31)) : R;
        voffA[i] = (unsigned)(R * K + C) * 2u; voffB[i] = (unsigned)(Rb * K + C) * 2u; }
    const size_t kstep = (size_t)(BK * 2);
    const size_t hstep = (size_t)HALF * K * 2;
    const size_t tstep = 2 * hstep;
    const unsigned ldsw = (unsigned)wid * 1024u;
    const int aoff = lds_byte(wr * 64 + fr, fq * 8), boff = lds_byte(wc * 32 + fr, fq * 8);
#define PG8_SA(b, h) (((b) * 2 + (h)) * HTB)
#define PG8_SB(b, h) ((4 + (b) * 2 + (h)) * HTB)
#define PG8_STAGE(bufoff, gbase, voff) do { _Pragma("unroll") for (int _i = 0; _i < 2; ++_i) \
        __builtin_amdgcn_global_load_lds((const unsigned*)((const char*)(gbase) + (voff)[_i]), (PG8_LAS unsigned*)(lds + (bufoff) + ldsw + _i * 8192), 16, 0, 0); } while (0)
#define PG8_LDA(dst, b, h) do { _Pragma("unroll") for (int m = 0; m < 4; ++m) _Pragma("unroll") for (int k = 0; k < 2; ++k) dst[m][k] = *(const PG8_LAS bf16x8*)(lds + PG8_SA(b, h) + aoff + m * 2048 + k * 1024); } while (0)
#define PG8_LDB(dst, b, h) do { _Pragma("unroll") for (int n = 0; n < 2; ++n) _Pragma("unroll") for (int k = 0; k < 2; ++k) dst[n][k] = *(const PG8_LAS bf16x8*)(lds + PG8_SB(b, h) + boff + n * 2048 + k * 1024); } while (0)
#define PG8_MMA(ai, bj, At, Bt) do { __builtin_amdgcn_s_setprio(1); _Pragma("unroll") for (int m = 0; m < 4; ++m) _Pragma("unroll") for (int n = 0; n < 2; ++n) _Pragma("unroll") for (int k = 0; k < 2; ++k) \
        acc[ai][bj][m][n] = __builtin_amdgcn_mfma_f32_16x16x32_bf16(Bt[n][k], At[m][k], acc[ai][bj][m][n], 0, 0, 0); __builtin_amdgcn_s_setprio(0); } while (0)
#define PG8_WAIT_V(n) asm volatile("s_waitcnt vmcnt(" #n ")" ::: "memory")
#define PG8_WAIT_L(n) asm volatile("s_waitcnt lgkmcnt(" #n ")" ::: "memory")
#define PG8_BAR __builtin_amdgcn_s_barrier()
#define PG8_SCHED __builtin_amdgcn_sched_barrier(0)
    Unit cur, nxt; int ui = 0;
    if (!S.next(0, cur)) return;
    f32x4 acc[2][2][4][2];
#pragma unroll
    for (int a = 0; a < 2; ++a)
#pragma unroll
        for (int b = 0; b < 2; ++b)
#pragma unroll
            for (int m = 0; m < 4; ++m)
#pragma unroll
                for (int n = 0; n < 2; ++n) acc[a][b][m][n] = (f32x4){0.f, 0.f, 0.f, 0.f};
    bf16x8 At[4][2], B0[2][2], B1[2][2];
    const char* cA = (const char*)g.A + (size_t)cur.pm * tstep; const char* cB = (const char*)g.Bt + (size_t)cur.pn * tstep;
    S.a_ready(cur);
    if constexpr (SP2) {
        PG8_STAGE(PG8_SB(0, 0), cB, voffB); PG8_STAGE(PG8_SB(0, 1), cB + hstep, voffB); PG8_STAGE(PG8_SA(0, 0), cA, voffA); PG8_STAGE(PG8_SA(0, 1), cA + hstep, voffA);
        if (wr == 1) PG8_BAR;
        PG8_WAIT_V(2); PG8_BAR;
        PG8_STAGE(PG8_SB(1, 0), cB + kstep, voffB); PG8_STAGE(PG8_SA(1, 0), cA + kstep, voffA); PG8_STAGE(PG8_SB(1, 1), cB + hstep + kstep, voffB);
        PG8_WAIT_V(6); PG8_BAR;
    } else {
        PG8_STAGE(PG8_SB(0, 0), cB, voffB); PG8_STAGE(PG8_SA(0, 0), cA, voffA); PG8_STAGE(PG8_SB(0, 1), cB + hstep, voffB); PG8_STAGE(PG8_SA(0, 1), cA + hstep, voffA);
        if (wr == 1) PG8_BAR;
        PG8_WAIT_V(4); PG8_BAR;
        PG8_STAGE(PG8_SB(1, 0), cB + kstep, voffB); PG8_STAGE(PG8_SA(1, 0), cA + kstep, voffA); PG8_STAGE(PG8_SB(1, 1), cB + hstep + kstep, voffB);
        PG8_WAIT_V(6); PG8_BAR;
    }
    for (;;) {
        const bool has_next = S.next(ui + 1, nxt);
        const char* nA = has_next ? (const char*)g.A + (size_t)nxt.pm * tstep : cA; const char* nB = has_next ? (const char*)g.Bt + (size_t)nxt.pn * tstep : cB;
        for (int t = 0; t < nt; t += 2) {
            const bool last = (t == nt - 2);
            const char* a1 = cA + (size_t)(t + 1) * kstep;
            const char* a2 = last ? nA : cA + (size_t)(t + 2) * kstep; const char* b2 = last ? nB : cB + (size_t)(t + 2) * kstep;
            const char* a3 = a2 + kstep; const char* b3 = b2 + kstep;
            if (last && has_next) S.a_ready(nxt);
            if constexpr (SP2) {
            PG8_LDB(B0, 0, 0); PG8_LDB(B1, 0, 1); PG8_SCHED; PG8_LDA(At, 0, 0); PG8_STAGE(PG8_SA(1, 1), a1 + hstep, voffA);
            PG8_WAIT_V(8); PG8_WAIT_L(0); PG8_BAR; PG8_MMA(0, 0, At, B0); PG8_MMA(0, 1, At, B1); PG8_BAR; PG8_SCHED;
            PG8_LDA(At, 0, 1); PG8_STAGE(PG8_SB(0, 0), b2, voffB); PG8_STAGE(PG8_SB(0, 1), b2 + hstep, voffB); PG8_STAGE(PG8_SA(0, 0), a2, voffA);
            PG8_WAIT_V(8); PG8_WAIT_L(0); PG8_BAR; PG8_MMA(1, 0, At, B0); PG8_MMA(1, 1, At, B1); PG8_BAR; PG8_SCHED;
            PG8_LDB(B0, 1, 0); PG8_LDB(B1, 1, 1); PG8_SCHED; PG8_LDA(At, 1, 0); PG8_STAGE(PG8_SA(0, 1), a2 + hstep, voffA);
            PG8_WAIT_V(8); PG8_WAIT_L(0); PG8_BAR; PG8_MMA(0, 0, At, B0); PG8_MMA(0, 1, At, B1); PG8_BAR; PG8_SCHED;
            PG8_LDA(At, 1, 1); PG8_STAGE(PG8_SB(1, 0), b3, voffB); PG8_STAGE(PG8_SB(1, 1), b3 + hstep, voffB); PG8_STAGE(PG8_SA(1, 0), a3, voffA);
            PG8_WAIT_V(8); PG8_WAIT_L(0); PG8_BAR; PG8_MMA(1, 0, At, B0); PG8_MMA(1, 1, At, B1); PG8_BAR; PG8_SCHED;
            } else {
            PG8_LDB(B0, 0, 0); PG8_SCHED; PG8_LDA(At, 0, 0); PG8_STAGE(PG8_SA(1, 1), a1 + hstep, voffA);
            PG8_WAIT_L(8); PG8_BAR; PG8_WAIT_L(0); PG8_MMA(0, 0, At, B0); PG8_BAR; PG8_SCHED;
            PG8_LDB(B1, 0, 1); PG8_STAGE(PG8_SB(0, 0), b2, voffB);
            PG8_BAR; PG8_WAIT_L(0); PG8_MMA(0, 1, At, B1); PG8_BAR;
            PG8_LDA(At, 0, 1); PG8_STAGE(PG8_SA(0, 0), a2, voffA);
            PG8_BAR; PG8_WAIT_L(0); PG8_MMA(1, 0, At, B0); PG8_BAR; PG8_SCHED;
            PG8_STAGE(PG8_SB(0, 1), b2 + hstep, voffB);
            PG8_WAIT_V(6); PG8_BAR; PG8_MMA(1, 1, At, B1); PG8_BAR;
            PG8_LDB(B0, 1, 0); PG8_SCHED; PG8_LDA(At, 1, 0); PG8_STAGE(PG8_SA(0, 1), a2 + hstep, voffA);
            PG8_WAIT_L(8); PG8_BAR; PG8_WAIT_L(0); PG8_MMA(0, 0, At, B0); PG8_BAR; PG8_SCHED;
            PG8_LDB(B1, 1, 1); PG8_STAGE(PG8_SB(1, 0), b3, voffB);
            PG8_BAR; PG8_WAIT_L(0); PG8_MMA(0, 1, At, B1); PG8_BAR;
            PG8_LDA(At, 1, 1); PG8_STAGE(PG8_SA(1, 0), a3, voffA);
            PG8_BAR; PG8_WAIT_L(0); PG8_MMA(1, 0, At, B0); PG8_BAR; PG8_SCHED;
            PG8_STAGE(PG8_SB(1, 1), b3 + hstep, voffB);
            PG8_WAIT_V(6); PG8_BAR; PG8_MMA(1, 1, At, B1); PG8_BAR;
            }
        }
        if constexpr (ALIGN_EPI) { if (wr == 0) PG8_BAR; }
        if constexpr (!Epi::AFTER_DRAIN) { E(acc, cur, wr, wc, fr, fq); S.done(cur); }
        if (!has_next) break;
#pragma unroll
        for (int a = 0; a < 2; ++a)
#pragma unroll
            for (int b = 0; b < 2; ++b)
#pragma unroll
                for (int m = 0; m < 4; ++m)
#pragma unroll
                    for (int n = 0; n < 2; ++n) acc[a][b][m][n] = (f32x4){0.f, 0.f, 0.f, 0.f};
        cur = nxt; cA = nA; cB = nB; ++ui;
        if constexpr (ALIGN_EPI) { if (wr == 1) PG8_BAR; }
    }
    PG8_WAIT_V(0);
    if constexpr (!ALIGN_EPI) { if (wr == 0) PG8_BAR; }
    PG8_BAR;
    if constexpr (Epi::AFTER_DRAIN) { E.fused(acc, cur, wr, wc, fr, fq, lds, wid, lane); S.done(cur); }
#undef PG8_SA
#undef PG8_SB
#undef PG8_STAGE
#undef PG8_LDA
#undef PG8_LDB
#undef PG8_MMA
#undef PG8_WAIT_V
#undef PG8_WAIT_L
#undef PG8_BAR
#undef PG8_SCHED
}
}

namespace attn_body {
using bf16=__hip_bfloat16;
using bf16x8=__attribute__((ext_vector_type(8)))short;
using s16x4=__attribute__((ext_vector_type(4)))short;
using f32x16=__attribute__((ext_vector_type(16)))float;
using u32x4=__attribute__((ext_vector_type(4)))unsigned;
using f32x4v=__attribute__((ext_vector_type(4)))float;
constexpr int BATCH=32,NHEAD=16,SEQ=2048,D=64,DM=NHEAD*D;
constexpr int NW=8,QBLK=32,QB=QBLK*NW,KVBLK=64,NQB=SEQ/QB;
constexpr int ATTN_PITCH=DM, ATTN_UNIT_ROWS=QB;
__device__ __forceinline__ int crow(int r,int hi){return (r&3)+8*(r>>2)+4*hi;}
#define SBAR() __builtin_amdgcn_sched_barrier(0)
__device__ __forceinline__ void cmask(f32x16&p0,f32x16&p1,int jb,int qrel,int hi){
  asm volatile("":"+v"(hi));
  const float NEG=-INFINITY; int kb=64*jb+4*hi;
  #pragma unroll
  for(int r=0;r<16;++r){int kv=kb+(r&3)+8*(r>>2); if(kv>qrel)p0[r]=NEG; if(kv+32>qrel)p1[r]=NEG;}
}

constexpr int NSLOT=3, SLOTB=8192;
constexpr int LDS_K=0, LDS_V=NSLOT*SLOTB, LDS_WS=2*NSLOT*SLOTB, LDS_OST=LDS_WS+NW*64*4, LDS_BYTES=LDS_OST+NW*4096;
constexpr int LDS_NF=86016, LDS_NFW=LDS_NF+8192;
constexpr float C2=0.125f*1.4426950408889634f;
__device__ __forceinline__ void glds16(const void*gsrc,unsigned lds_dst){unsigned keep;
  asm volatile("s_mov_b32 %0, m0\n\ts_mov_b32 m0, %2\n\ts_nop 0\n\tglobal_load_lds_dwordx4 %1, off\n\ts_mov_b32 m0, %0":"=&s"(keep):"v"(gsrc),"s"(lds_dst):"memory");}
__device__ __forceinline__ float max3f(float a,float b,float c){float r;asm("v_max3_f32 %0, %1, %2, %3":"=v"(r):"v"(a),"v"(b),"v"(c));return r;}
__device__ __forceinline__ float max2f(float a,float b){float r;asm("v_max_f32_e32 %0, %1, %2":"=v"(r):"v"(a),"v"(b));return r;}
__device__ __forceinline__ float fadd_s(float a,float b){float r;asm("v_add_f32_e32 %0, %1, %2":"=v"(r):"v"(a),"v"(b));return r;}
__device__ __forceinline__ float fsub_s(float a,float b){float r;asm("v_sub_f32_e32 %0, %1, %2":"=v"(r):"v"(a),"v"(b));return r;}
typedef float f32x2_t __attribute__((ext_vector_type(2))); typedef __bf16 bf16x2_t __attribute__((ext_vector_type(2)));
__device__ __forceinline__ unsigned cvtpk_s(float lo,float hi){f32x2_t v={lo,hi};bf16x2_t b=__builtin_convertvector(v,bf16x2_t);return __builtin_bit_cast(unsigned,b);}
#define WAIT_BAR(N) asm volatile("s_waitcnt vmcnt(" #N ") lgkmcnt(0)\n\ts_barrier":::"memory")

__device__ __forceinline__ void qkt(f32x16&p0,f32x16&p1,const char*Kslot,const bf16x8*qr,const f32x16&negm,int r32,int hi){
  const char*kb=Kslot+hi*1024+r32*16;
  #pragma unroll
  for(int d0=0;d0<4;++d0){
    const bf16x8 b0=*reinterpret_cast<const bf16x8*>(kb+d0*2048);
    const bf16x8 b1=*reinterpret_cast<const bf16x8*>(kb+d0*2048+512);
    if(d0==0){p0=__builtin_amdgcn_mfma_f32_32x32x16_bf16(b0,qr[0],negm,0,0,0);p1=__builtin_amdgcn_mfma_f32_32x32x16_bf16(b1,qr[0],negm,0,0,0);}
    else{p0=__builtin_amdgcn_mfma_f32_32x32x16_bf16(b0,qr[d0],p0,0,0,0);p1=__builtin_amdgcn_mfma_f32_32x32x16_bf16(b1,qr[d0],p1,0,0,0);}}
}
typedef __attribute__((address_space(3))) const char* lds_cptr;
typedef short v4i16_t __attribute__((ext_vector_type(4)));
__device__ __forceinline__ void kload8(bf16x8*kf,lds_cptr kp){
  kf[0]=*(const __attribute__((address_space(3))) bf16x8*)(kp);      kf[1]=*(const __attribute__((address_space(3))) bf16x8*)(kp+512);
  kf[2]=*(const __attribute__((address_space(3))) bf16x8*)(kp+2048); kf[3]=*(const __attribute__((address_space(3))) bf16x8*)(kp+2560);
  kf[4]=*(const __attribute__((address_space(3))) bf16x8*)(kp+4096); kf[5]=*(const __attribute__((address_space(3))) bf16x8*)(kp+4608);
  kf[6]=*(const __attribute__((address_space(3))) bf16x8*)(kp+6144); kf[7]=*(const __attribute__((address_space(3))) bf16x8*)(kp+6656);
}
__device__ __forceinline__ void kload2(bf16x8*kf,lds_cptr kp,int j){ kf[2*j]=*(const __attribute__((address_space(3))) bf16x8*)(kp+j*2048); kf[2*j+1]=*(const __attribute__((address_space(3))) bf16x8*)(kp+j*2048+512); }
__device__ __forceinline__ s16x4 vtr(lds_cptr p){ return __builtin_bit_cast(s16x4,__builtin_amdgcn_ds_read_tr16_b64_v4i16((__attribute__((address_space(3))) v4i16_t*)p)); }
__device__ __forceinline__ float rowmax(const f32x16&p0,const f32x16&p1){
  float a=max3f(p0[0],p0[1],p1[0]),b=max3f(p0[2],p0[3],p1[1]);a=max3f(a,p1[2],p1[3]);
  #pragma unroll
  for(int r=4;r<16;r+=4){a=max3f(a,p0[r],p0[r+1]);b=max3f(b,p0[r+2],p0[r+3]);a=max3f(a,p1[r],p1[r+1]);b=max3f(b,p1[r+2],p1[r+3]);}
  const float m=max2f(a,b);
  auto rr=__builtin_amdgcn_permlane32_swap(__float_as_uint(m),__float_as_uint(m),false,false);
  return max2f(__uint_as_float(rr[0]),__uint_as_float(rr[1]));
}
__device__ __forceinline__ void pv(f32x16*o,int vb,bf16x8 pa0,bf16x8 pa1,bf16x8 pa2,bf16x8 pa3){
  #pragma unroll
  for(int d0=0;d0<2;++d0){s16x4 lo[4],hi[4];
    #pragma unroll
    for(int ks=0;ks<4;++ks){
      asm volatile("ds_read_b64_tr_b16 %0,%1 offset:%c2":"=&v"(lo[ks]):"v"(vb),"i"(d0*4096+ks*1024):"memory");
      asm volatile("ds_read_b64_tr_b16 %0,%1 offset:%c2":"=&v"(hi[ks]):"v"(vb),"i"(d0*4096+ks*1024+512):"memory");}
    asm volatile("s_waitcnt lgkmcnt(0)":::"memory");SBAR();
    #define PK(k) (bf16x8){lo[k][0],lo[k][1],lo[k][2],lo[k][3],hi[k][0],hi[k][1],hi[k][2],hi[k][3]}
    o[d0]=__builtin_amdgcn_mfma_f32_32x32x16_bf16(pa0,PK(0),o[d0],0,0,0);
    o[d0]=__builtin_amdgcn_mfma_f32_32x32x16_bf16(pa1,PK(1),o[d0],0,0,0);
    o[d0]=__builtin_amdgcn_mfma_f32_32x32x16_bf16(pa2,PK(2),o[d0],0,0,0);
    o[d0]=__builtin_amdgcn_mfma_f32_32x32x16_bf16(pa3,PK(3),o[d0],0,0,0);
    #undef PK
  }
}

#ifndef ATTN_STORE16
#define ATTN_STORE16(p,v) (*(u32x4*)(p)=(v))
#endif
template<int THRL> __device__ __forceinline__ void attn_unit(int b,int h,int qb,const bf16*Q,const bf16*__restrict__ K,const bf16*__restrict__ V,bf16*O,char*shm,int tid_){
  asm volatile("":"+v"(tid_));
  const int tid=tid_,lane=tid&63,r32=lane&31,hi=lane>>5; const int wid=__builtin_amdgcn_readfirstlane(tid>>6);
  const long rowbase=(long)b*SEQ; const int q0=qb*QB;
  const bf16*Qw=Q+(rowbase+q0+wid*QBLK)*DM+h*D;
  const bf16*Kh=K+rowbase*DM+h*D,*Vh=V+rowbase*DM+h*D;
  const unsigned lds0=(unsigned)(uintptr_t)shm;
  float*wsf=(float*)(shm+LDS_WS)+wid*64;
  const bf16*ksrc=Kh+(long)lane*DM+wid*8;
  const bf16*vsrc=Vh+(long)(16*(wid&3)+(lane>>2))*DM+(wid>>2)*32+(lane&3)*8;
  const unsigned kdst=lds0+LDS_K+wid*1024, vdst=lds0+LDS_V+wid*1024;
  #define DMA_K(t,slot) glds16(ksrc+(long)(t)*KVBLK*DM,(unsigned)__builtin_amdgcn_readfirstlane(kdst+(slot)))
  #define DMA_V(t,slot) glds16(vsrc+(long)(t)*KVBLK*DM,(unsigned)__builtin_amdgcn_readfirstlane(vdst+(slot)))
  const int vb0=(int)(lds0+LDS_V)+((lane>>4)&1)*32+(lane&3)*8+(4*hi+((lane&15)>>2))*64;
  const char*Kbase=shm+LDS_K; bf16x8 kf[8];
  const lds_cptr shm3=(lds_cptr)shm; const lds_cptr kp0=shm3+LDS_K+hi*1024+r32*16; const lds_cptr vp0=shm3+LDS_V+((lane>>4)&1)*32+(lane&3)*8+(4*hi+((lane&15)>>2))*64;
  const int NT=(q0+QB)/KVBLK;
  DMA_K(0,0);DMA_V(0,0);DMA_K(1,SLOTB);
  bf16x8 qr[4];
  #pragma unroll
  for(int d0=0;d0<4;++d0)qr[d0]=*reinterpret_cast<const bf16x8*>(&Qw[(long)r32*DM+d0*16+hi*8]);
  float mhat=0.f,l_reg=0.f;f32x16 o[2]; { float z_=0.f; asm volatile("":"+v"(z_));
    _Pragma("unroll") for(int r=0;r<16;++r){o[0][r]=z_;o[1][r]=z_;} }
  const f32x16 negm=f32x16{};
  const int qrel=wid*QBLK+r32;
  const __attribute__((address_space(3))) char* shm3n=(const __attribute__((address_space(3))) char*)shm;
  #define CMASK(P0,P1,t) do{int jb_=(t)-(NT-4); if(jb_>=0)cmask(P0,P1,jb_,qrel,hi);}while(0)
  const __attribute__((address_space(3))) f32x4v* nfp=(const __attribute__((address_space(3))) f32x4v*)(shm3n+LDS_NF)+hi;
  #define BIAS(P0,P1,t) do{ _Pragma("unroll") for(int a_=0;a_<4;++a_){ const f32x4v b0_=nfp[16*(t)+2*a_], b1_=nfp[16*(t)+2*a_+8]; \
      _Pragma("unroll") for(int i_=0;i_<4;++i_){ P0[4*a_+i_]+=(b0_[i_]-mhat); P1[4*a_+i_]+=(b1_[i_]-mhat); } } }while(0)
  bool resc=false;
  #define START(P0,P1) do{ const float rm=rowmax(P0,P1); resc=false; \
    { const float dl=rm; mhat=fadd_s(mhat,dl); \
      _Pragma("unroll") for(int r=0;r<16;++r){P0[r]=fsub_s(P0[r],dl);P1[r]=fsub_s(P1[r],dl);} \
      } \
    _Pragma("unroll") for(int r=0;r<16;++r)P0[r]=__builtin_amdgcn_exp2f(P0[r]); }while(0)
  #define RESC() do{ if(resc){ asm volatile("s_waitcnt lgkmcnt(0)":::"memory"); \
      _Pragma("unroll") for(int d_=0;d_<2;++d_) _Pragma("unroll") for(int r=0;r<16;++r)o[d_][r]*=wsf[crow(r,hi)]; } }while(0)
  f32x16 pA0,pA1,pB0,pB1;
  int sl_prev=0,sl_cur=0,sl_next=SLOTB;
  #define ROT() do{sl_prev=sl_cur;sl_cur=sl_next;sl_next=(sl_next==(NSLOT-1)*SLOTB)?0:sl_next+SLOTB;}while(0)
  DMA_K(2,2*SLOTB);
  WAIT_BAR(3);
  qkt(pA0,pA1,Kbase,qr,negm,r32,hi);asm volatile("s_nop 15\n\ts_nop 7":"+v"(pA0),"+v"(pA1));BIAS(pA0,pA1,0);CMASK(pA0,pA1,0);
  START(pA0,pA1);
  _Pragma("unroll") for(int r=0;r<16;++r)pA1[r]=__builtin_amdgcn_exp2f(pA1[r]);
  WAIT_BAR(0);
  DMA_K(3,0);DMA_V(1,SLOTB);
  ROT();
  kload8(kf,kp0+sl_cur);
  WAIT_BAR(2);
  s16x4 vlo[8],vhi[8]; u32x4 pw0,pw1,pw2,pw3;
  #define PKW(P,B) cvtpk_s(P[B],P[B+1])
  #define PAF(k) __builtin_bit_cast(bf16x8,pw##k)
  #define VFR(i) (bf16x8){vlo[i][0],vlo[i][1],vlo[i][2],vlo[i][3],vhi[i][0],vhi[i][1],vhi[i][2],vhi[i][3]}
  #define PIN(x) asm volatile("":"+v"(x))
  #define MX3(a,b,c) __builtin_fmaxf(__builtin_fmaxf((a),(b)),(c))
  #define GAPA(MF,A0,A1,A2,A3,W0,W1,PW) do{ MF; sacc+=A0; sacc+=A1; sacc+=A2; sacc+=A3; PIN(sacc); W0; W1; PIN(PW); SBAR(); }while(0)
  #define EX(v) __builtin_amdgcn_exp2f(v)
  #define GAPB(MF,X,B) do{ MF; X[B]=EX(X[B]); X[B+1]=EX(X[B+1]); X[B+2]=EX(X[B+2]); X[B+3]=EX(X[B+3]); PIN(X); SBAR(); }while(0)
  #define VRD(i) do{ vlo[i]=vtr(vp_+(((i)>>2)*4096+((i)&3)*1024)); vhi[i]=vtr(vp_+(((i)>>2)*4096+((i)&3)*1024+512)); }while(0)
  #define KRD(G,j) do{ if(G){ kload2(kf,kp0+sl_next,j); SBAR(); } }while(0)
  #define STEP(C0,C1,P0,P1,t,GK,GV,GL) do{ SBAR(); \
    const lds_cptr vp_=vp0+sl_prev; \
    VRD(0); SBAR(); float sacc=(P0[0]+P0[1]); \
    GAPA(C0=__builtin_amdgcn_mfma_f32_32x32x16_bf16(kf[0],qr[0],negm,0,0,0), P0[2],P0[3],P0[4],P0[5],     pw0[0]=PKW(P0,0), pw0[1]=PKW(P0,2), pw0); \
    VRD(4); SBAR(); GAPA(C1=__builtin_amdgcn_mfma_f32_32x32x16_bf16(kf[1],qr[0],negm,0,0,0), P0[6],P0[7],P0[8],P0[9],     pw0[2]=PKW(P0,4), pw0[3]=PKW(P0,6), pw0); \
    VRD(1); SBAR(); GAPA(C0=__builtin_amdgcn_mfma_f32_32x32x16_bf16(kf[2],qr[1],C0,0,0,0),   P0[10],P0[11],P0[12],P0[13], pw1[0]=PKW(P0,8), pw1[1]=PKW(P0,10), pw1); \
    VRD(5); SBAR(); GAPA(C1=__builtin_amdgcn_mfma_f32_32x32x16_bf16(kf[3],qr[1],C1,0,0,0),   P0[14],P0[15],P1[0],P1[1],   pw1[2]=PKW(P0,12),pw1[3]=PKW(P0,14), pw1); \
    VRD(2); SBAR(); GAPA(C0=__builtin_amdgcn_mfma_f32_32x32x16_bf16(kf[4],qr[2],C0,0,0,0),   P1[2],P1[3],P1[4],P1[5],     pw2[0]=PKW(P1,0), pw2[1]=PKW(P1,2), pw2); \
    VRD(6); SBAR(); GAPA(C1=__builtin_amdgcn_mfma_f32_32x32x16_bf16(kf[5],qr[2],C1,0,0,0),   P1[6],P1[7],P1[8],P1[9],     pw2[2]=PKW(P1,4), pw2[3]=PKW(P1,6), pw2); \
    VRD(3); SBAR(); GAPA(C0=__builtin_amdgcn_mfma_f32_32x32x16_bf16(kf[6],qr[3],C0,0,0,0),   P1[10],P1[11],P1[12],P1[13], pw3[0]=PKW(P1,8), pw3[1]=PKW(P1,10), pw3); \
    VRD(7); SBAR(); GAPA(C1=__builtin_amdgcn_mfma_f32_32x32x16_bf16(kf[7],qr[3],C1,0,0,0),   P1[14],P1[15],0.f,0.f,       pw3[2]=PKW(P1,12),pw3[3]=PKW(P1,14), pw3); \
    l_reg+=sacc; \
    if(GK){DMA_K((t)+3,sl_cur);} if(GV){DMA_V((t)+1,sl_next);} \
    BIAS(C0,C1,t); CMASK(C0,C1,t); \
    { float a=MX3(C0[0],C0[1],C1[0]),b=MX3(C0[2],C0[3],C1[1]); a=MX3(a,C1[2],C1[3]); \
      _Pragma("unroll") for(int r=4;r<16;r+=4){a=MX3(a,C0[r],C0[r+1]);b=MX3(b,C0[r+2],C0[r+3]);a=MX3(a,C1[r],C1[r+1]);b=MX3(b,C1[r+2],C1[r+3]);} \
      float rm=__builtin_fmaxf(a,b); { auto rr=__builtin_amdgcn_permlane32_swap(__float_as_uint(rm),__float_as_uint(rm),false,false); rm=__builtin_fmaxf(__uint_as_float(rr[0]),__uint_as_float(rr[1])); } \
      resc=false; \
      if(__builtin_expect(__any(rm>(float)THRL),0)){ const float dl=__builtin_fmaxf(rm,0.f); mhat+=dl; \
        _Pragma("unroll") for(int r=0;r<16;++r){C0[r]-=dl;C1[r]-=dl;} \
        const float f=__builtin_amdgcn_exp2f(-dl); l_reg*=f; if(hi==0)wsf[r32]=f; resc=true; } } \
    SBAR(); \
    GAPB(o[0]=__builtin_amdgcn_mfma_f32_32x32x16_bf16(PAF(0),VFR(0),o[0],0,0,0), C0,0); \
    GAPB(o[1]=__builtin_amdgcn_mfma_f32_32x32x16_bf16(PAF(0),VFR(4),o[1],0,0,0), C0,4); \
    KRD(GL,0); GAPB(o[0]=__builtin_amdgcn_mfma_f32_32x32x16_bf16(PAF(1),VFR(1),o[0],0,0,0), C0,8); \
    KRD(GL,1); GAPB(o[1]=__builtin_amdgcn_mfma_f32_32x32x16_bf16(PAF(1),VFR(5),o[1],0,0,0), C0,12); \
    KRD(GL,2); GAPB(o[0]=__builtin_amdgcn_mfma_f32_32x32x16_bf16(PAF(2),VFR(2),o[0],0,0,0), C1,0); \
    KRD(GL,3); GAPB(o[1]=__builtin_amdgcn_mfma_f32_32x32x16_bf16(PAF(2),VFR(6),o[1],0,0,0), C1,4); \
    GAPB(o[0]=__builtin_amdgcn_mfma_f32_32x32x16_bf16(PAF(3),VFR(3),o[0],0,0,0), C1,8); \
    GAPB(o[1]=__builtin_amdgcn_mfma_f32_32x32x16_bf16(PAF(3),VFR(7),o[1],0,0,0), C1,12); \
    }while(0)
  int t=1;
  #undef CMASK
  #define CMASK(P0,P1,t) do{}while(0)
  for(;t+5<NT;t+=2){
    STEP(pB0,pB1,pA0,pA1,t,true,true,true);     WAIT_BAR(2); RESC(); ROT();
    STEP(pA0,pA1,pB0,pB1,t+1,true,true,true);   WAIT_BAR(2); RESC(); ROT();
  }
  #undef CMASK
  #define CMASK(P0,P1,t) do{int jb_=(t)-(NT-4); if(jb_>=0)cmask(P0,P1,jb_,qrel,hi);}while(0)
  #define ENDW(tt) do{ if((tt)+3<NT){WAIT_BAR(2);} else if((tt)+2<NT){WAIT_BAR(1);} else {WAIT_BAR(0);} }while(0)
  for(;t+1<NT;t+=2){
    STEP(pB0,pB1,pA0,pA1,t,(t+3<NT),(t+1<NT),(t+1<NT));       ENDW(t);   RESC(); ROT();
    STEP(pA0,pA1,pB0,pB1,t+1,(t+4<NT),(t+2<NT),(t+2<NT));     ENDW(t+1); RESC(); ROT();
  }
  STEP(pB0,pB1,pA0,pA1,NT-1,false,false,false); RESC();
  { float sacc=pB0[0]+pB0[1]; _Pragma("unroll") for(int r=2;r<16;++r)sacc+=pB0[r]; _Pragma("unroll") for(int r=0;r<16;++r)sacc+=pB1[r]; l_reg+=sacc;
    pw0=(u32x4){PKW(pB0,0),PKW(pB0,2),PKW(pB0,4),PKW(pB0,6)};pw1=(u32x4){PKW(pB0,8),PKW(pB0,10),PKW(pB0,12),PKW(pB0,14)};pw2=(u32x4){PKW(pB1,0),PKW(pB1,2),PKW(pB1,4),PKW(pB1,6)};pw3=(u32x4){PKW(pB1,8),PKW(pB1,10),PKW(pB1,12),PKW(pB1,14)};
    SBAR(); pv(o,vb0+sl_cur,PAF(0),PAF(1),PAF(2),PAF(3)); }
  #undef PKW
  #undef PAF
  #undef VFR
  #undef PIN
  #undef MX3
  #undef GAPA
  #undef GAPB
  #undef EX
  #undef VRD
  #undef KRD
  #undef STEP
  #undef ENDW
  {auto rr=__builtin_amdgcn_permlane32_swap(__float_as_uint(l_reg),__float_as_uint(l_reg),false,false);l_reg=__uint_as_float(rr[0])+__uint_as_float(rr[1]);}
  if(hi==0)wsf[32+r32]=l_reg;asm volatile("s_waitcnt lgkmcnt(0)":::"memory");
  float rli[16];
  #pragma unroll
  for(int r=0;r<16;++r)rli[r]=__builtin_amdgcn_rcpf(wsf[32+crow(r,hi)]);
  bf16*Ow=O+(rowbase+q0+wid*QBLK)*DM+h*D;
  { bf16*stg=(bf16*)(shm+LDS_OST)+wid*2048;
    #pragma unroll
    for(int r=0;r<16;++r){const int orow=crow(r,hi);
      #pragma unroll
      for(int d0=0;d0<2;++d0)stg[orow*64+d0*32+r32]=__float2bfloat16(o[d0][r]*rli[r]);}
    asm volatile("s_waitcnt lgkmcnt(0)":::"memory");
    #pragma unroll
    for(int i=0;i<4;++i){const int row=i*8+(lane>>3),ch=lane&7; const u32x4 v=*(const u32x4*)(stg+row*64+ch*8); ATTN_STORE16(Ow+(long)row*DM+ch*8,v);} }
  asm volatile("s_waitcnt lgkmcnt(0)\n\ts_barrier":::"memory");
  #undef BIAS
  #undef DMA_K
  #undef DMA_V
  #undef CMASK
  #undef START
  #undef RESC
  #undef ROT
}
constexpr int ATTN_LDS_BYTES=LDS_BYTES;
#undef SBAR
#undef WAIT_BAR
}
constexpr size_t MiB = 1u << 20;
constexpr size_t ACT = (size_t)MT * DMODEL * 2;
constexpr size_t WS_CTL = 0;
constexpr size_t WS_MOD = 1 * MiB, WS_MODF = 3 * MiB;
constexpr size_t WS_W13A = 4 * MiB, WS_W2A = 16 * MiB, WS_W13B = 22 * MiB, WS_W2B = 34 * MiB, WS_WIN = 40 * MiB, WS_WR = 56 * MiB, WS_WA = 58 * MiB, WS_WO = 60 * MiB, WS_RGW = 62 * MiB;
constexpr size_t WS_HN = 64 * MiB, WS_XR = WS_HN + ACT, WS_GR = WS_XR + ACT, WS_Q = WS_GR + ACT, WS_K = WS_Q + ACT, WS_V = WS_K + ACT, WS_END = WS_V + ACT;
constexpr size_t WS_G = WS_XR;
static_assert(WS_G + (size_t)MT * DFF * 2 <= WS_K && WS_END + 2 * (size_t)MT * DMODEL <= 1024 * MiB, "ws map");
constexpr int WIN_ROWS = 7424;
constexpr size_t O_Y = 0, O_KP = 67371008, O_VP = 134479872, O_LFP = 201588736, O_CVP = 202637312, O_HP = 202735616, O_KS = 202768384, O_VS = 203030528, O_LFS = 203292672, O_CVS = 203296768, O_HS = 203345920;
constexpr int RING_BYTES = 131072, LDS_BYTES = 147456;
constexpr int NWAVES = 8, NPHASE = 15;

#define LAS __attribute__((address_space(3)))
typedef unsigned short bf16;
typedef unsigned v4u __attribute__((ext_vector_type(4)));
typedef unsigned v2u __attribute__((ext_vector_type(2)));
typedef float f32x4 __attribute__((ext_vector_type(4)));
typedef short bf16x8 __attribute__((ext_vector_type(8)));
#define LDS_WAIT() asm volatile("s_waitcnt lgkmcnt(0)" ::: "memory")
__device__ __forceinline__ unsigned f2bf(float f) { unsigned u = __builtin_bit_cast(unsigned, f); return (u + 0x7fffu + ((u >> 16) & 1u)) >> 16; }
__device__ __forceinline__ unsigned pk2(float lo, float hi) { return f2bf(lo) | (f2bf(hi) << 16); }
__device__ __forceinline__ float bf2f(unsigned short h) { return __uint_as_float((unsigned)h << 16); }
__device__ __forceinline__ float wave_sum(float v) {
#pragma unroll
    for (int o = 1; o < 64; o <<= 1) v += __shfl_xor(v, o);
    return v;
}

struct Params {
    const float *x_prompt, *x_sample, *cache_k, *cache_v, *cache_logf, *state_conv, *state_rglru, *c_prompt, *c_sample, *w_ada, *b_ada;
    const float *ffn1_norm, *ffn1_w1, *ffn1_w3, *ffn1_w2, *mix_norm, *w_in, *b_fgt, *conv_w, *conv_b, *rg_wa, *rg_ba, *rg_wx, *rg_bx, *rg_lam;
    const float *w_br_rnn, *w_br_att, *w_out, *ffn2_norm, *ffn2_w1, *ffn2_w3, *ffn2_w2, *final_norm, *w_ada_f, *b_ada_f;
    float* out; unsigned char* ws; int ph_lo, ph_hi;
};

template <int MODE> __device__ __forceinline__ void p0_transpose_item(const float* W, int ldw, int nblk, bf16* WT, int ldt, int row_off, LAS float* scr, int item, int lane) {
    const int kb = item / nblk, nb = item % nblk, k0 = 64 * kb, n0 = 32 * nb;
#pragma unroll 8
    for (int i = 0; i < 32; ++i) { const int kk = 2 * i + (lane >> 5); scr[kk * 33 + (lane & 31)] = W[(size_t)(k0 + kk) * ldw + n0 + (lane & 31)]; }
    LDS_WAIT(); asm volatile("" ::: "memory");
    const int c = lane & 7;
#pragma unroll
    for (int j = 0; j < 4; ++j) { const int n = (lane >> 3) + 8 * j; const LAS float* s = scr + (8 * c) * 33 + n;
        v4u o; o.x = pk2(s[0 * 33], s[1 * 33]); o.y = pk2(s[2 * 33], s[3 * 33]); o.z = pk2(s[4 * 33], s[5 * 33]); o.w = pk2(s[6 * 33], s[7 * 33]);
        const int nn = n0 + n; const int row = (MODE == 1) ? ((nn >> 7) * 256 + (nn & 127) + row_off) : (row_off + nn);
        *(v4u*)(WT + (size_t)row * ldt + k0 + 8 * c) = o; }
    LDS_WAIT(); asm volatile("" ::: "memory");
}

__device__ __forceinline__ void p0_ada_item(const Params& P, LAS unsigned char* lds, int cgi, int wave, int lane, int tid) {
    const bool fin = cgi >= 144; const int col = fin ? (cgi - 144) * 64 + lane : cgi * 64 + lane; const int ldw = fin ? 2 * DMODEL : NMOD * DMODEL;
    const float* W = (fin ? P.w_ada_f : P.w_ada) + col;
    LAS float* sw = (LAS float*)(lds + wave * 12288);
    float acc[NBT];
#pragma unroll
    for (int b = 0; b < NBT; ++b) acc[b] = 0.f;
    for (int p = 0; p < 2; ++p) {
        const int k0 = 128 * wave + 64 * p;
#pragma unroll
        for (int b = 0; b < NBT; ++b) { const float c = (b < NB_P) ? P.c_prompt[b * DMODEL + k0 + lane] : P.c_sample[(b - NB_P) * DMODEL + k0 + lane]; sw[b * 64 + lane] = c / (1.0f + __expf(-c)); }
        LDS_WAIT(); asm volatile("" ::: "memory");
#pragma unroll 4
        for (int k4 = 0; k4 < 16; ++k4) {
            const float w0 = W[(size_t)(k0 + 4 * k4 + 0) * ldw], w1 = W[(size_t)(k0 + 4 * k4 + 1) * ldw], w2 = W[(size_t)(k0 + 4 * k4 + 2) * ldw], w3 = W[(size_t)(k0 + 4 * k4 + 3) * ldw];
#pragma unroll
            for (int b = 0; b < NBT; ++b) { const f32x4 s = *(const LAS f32x4*)(sw + b * 64 + 4 * k4); acc[b] += (s[0] * w0 + s[1] * w1) + (s[2] * w2 + s[3] * w3); }
        }
        LDS_WAIT(); asm volatile("" ::: "memory");
    }
#pragma unroll
    for (int b = 0; b < NBT; ++b) sw[b * 64 + lane] = acc[b];
    __syncthreads();
    for (int i = 0; i < 6; ++i) { const int idx = tid + 512 * i, b = idx >> 6, ln = idx & 63; float s = 0.f;
#pragma unroll
        for (int w = 0; w < 8; ++w) s += *((const LAS float*)(lds + w * 12288) + b * 64 + ln);
        const int cc = fin ? (cgi - 144) * 64 + ln : cgi * 64 + ln;
        if (fin) ((float*)(P.ws + WS_MODF))[b * (2 * DMODEL) + cc] = s + P.b_ada_f[cc];
        else ((float*)(P.ws + WS_MOD))[b * (NMOD * DMODEL) + cc] = s + P.b_ada[cc]; }
    __syncthreads();
}

__device__ __forceinline__ void p0_ada(const Params& P, LAS unsigned char* lds, int wave, int lane, int tid) {
    const int G = gridDim.x;
    for (int cgi = blockIdx.x; cgi < 176; cgi += G) p0_ada_item(P, lds, cgi, wave, lane, tid);
}
__device__ __forceinline__ void p0_prologue(const Params& P, LAS unsigned char* lds, int wave, int lane, int tid, int ilo, int ihi, int gw, int NGW) {
    const int G = gridDim.x;
    LAS float* scr = (LAS float*)(lds + wave * 16384);
    bf16* W13A = (bf16*)(P.ws + WS_W13A); bf16* W2A = (bf16*)(P.ws + WS_W2A); bf16* W13B = (bf16*)(P.ws + WS_W13B); bf16* W2B = (bf16*)(P.ws + WS_W2B);
    bf16* WIN = (bf16*)(P.ws + WS_WIN); bf16* WR = (bf16*)(P.ws + WS_WR); bf16* WA = (bf16*)(P.ws + WS_WA); bf16* WO = (bf16*)(P.ws + WS_WO); bf16* RGW = (bf16*)(P.ws + WS_RGW);
    constexpr int I_UP = 16 * 88, I_DN = 44 * 32, I_IN1 = 16 * 160, I_IN2 = 16 * 64, I_SQ = 16 * 32, I_RG = 32, I_FL = 128;
    constexpr int NITEMS = 4 * I_UP + 2 * I_DN + I_IN1 + I_IN2 + 3 * I_SQ + 2 * I_RG + I_FL;
    if (ihi > NITEMS) ihi = NITEMS;
    for (int it = ilo + gw; it < ihi; it += NGW) {
        int r = it;
        if (r < I_UP) { p0_transpose_item<1>(P.ffn1_w1, DFF, 88, W13A, DMODEL, 0, scr, r, lane); continue; } r -= I_UP;
        if (r < I_UP) { p0_transpose_item<1>(P.ffn1_w3, DFF, 88, W13A, DMODEL, 128, scr, r, lane); continue; } r -= I_UP;
        if (r < I_UP) { p0_transpose_item<1>(P.ffn2_w1, DFF, 88, W13B, DMODEL, 0, scr, r, lane); continue; } r -= I_UP;
        if (r < I_UP) { p0_transpose_item<1>(P.ffn2_w3, DFF, 88, W13B, DMODEL, 128, scr, r, lane); continue; } r -= I_UP;
        if (r < I_DN) { p0_transpose_item<0>(P.ffn1_w2, DMODEL, 32, W2A, DFF, 0, scr, r, lane); continue; } r -= I_DN;
        if (r < I_DN) { p0_transpose_item<0>(P.ffn2_w2, DMODEL, 32, W2B, DFF, 0, scr, r, lane); continue; } r -= I_DN;
        if (r < I_IN1) { p0_transpose_item<0>(P.w_in, INCOLS, 160, WIN, DMODEL, 0, scr, r, lane); continue; } r -= I_IN1;
        if (r < I_IN2) { p0_transpose_item<0>(P.w_in + 5136, INCOLS, 64, WIN, DMODEL, 5376, scr, r, lane); continue; } r -= I_IN2;
        if (r < I_SQ) { p0_transpose_item<0>(P.w_br_rnn, DMODEL, 32, WR, DMODEL, 0, scr, r, lane); continue; } r -= I_SQ;
        if (r < I_SQ) { p0_transpose_item<0>(P.w_br_att, DMODEL, 32, WA, DMODEL, 0, scr, r, lane); continue; } r -= I_SQ;
        if (r < I_SQ) { p0_transpose_item<0>(P.w_out, DMODEL, 32, WO, DMODEL, 0, scr, r, lane); continue; } r -= I_SQ;
        if (r < 2 * I_RG) { const int mat = r / I_RG, rr = r % I_RG, blk = rr >> 1, sub = rr & 1;
            p0_transpose_item<0>((mat ? P.rg_wx : P.rg_wa) + blk * 4096, 64, 2, RGW + mat * 65536 + blk * 4096, 64, 0, scr, sub, lane); continue; } r -= 2 * I_RG;
        {
#pragma unroll
            for (int h2 = 0; h2 < 2; ++h2) { const int j = 2 * r + h2; bf16* dst = WIN + (size_t)(5120 + j) * DMODEL + lane * 16;
                unsigned w[8];
#pragma unroll
                for (int q = 0; q < 8; ++q) { float a = 0.f, b = 0.f; if (j < 16) { a = P.w_in[(size_t)(lane * 16 + 2 * q) * INCOLS + 5120 + j]; b = P.w_in[(size_t)(lane * 16 + 2 * q + 1) * INCOLS + 5120 + j]; } w[q] = pk2(a, b); }
                *(v4u*)dst = (v4u){w[0], w[1], w[2], w[3]}; *(v4u*)(dst + 8) = (v4u){w[4], w[5], w[6], w[7]}; }
        }
    }
}

template <bool OUT_F32, bool IN_BF16> __device__ __forceinline__ void norm_phase(const float* srcP, const float* srcS, const bf16* srcB, const float* gvec, const float* modbase, int modstride, int jshift, int jscale,
                                                                   bf16* outb, float* outf, int wave, int lane) {
    const int gw = blockIdx.x * NWAVES + wave, NGW = gridDim.x * NWAVES; const bool xa = (gridDim.x == 256);
    for (int g0 = gw; g0 < MT / 32; g0 += NGW) {
        const int grp = (xa && g0 < MP / 32) ? (8 * (32 * ((int)blockIdx.x & 7) + ((int)blockIdx.x >> 3)) + wave) : g0;
        const int r0 = grp * 32; int bprev = -1; f32x4 gs[4], sh[4];
        for (int i = 0; i < 32; i += 4) {
            const int r = r0 + i, b = batch_of_row(r);
            if (b != bprev) { bprev = b;
#pragma unroll
                for (int j = 0; j < 4; ++j) { const int c = 4 * lane + 256 * j; const f32x4 g = *(const f32x4*)(gvec + c), sc = *(const f32x4*)(modbase + (size_t)b * modstride + jscale * DMODEL + c);
                    gs[j] = g * (sc + 1.0f); sh[j] = *(const f32x4*)(modbase + (size_t)b * modstride + jshift * DMODEL + c); } }
            f32x4 v[4][4]; float ss[4];
            if (IN_BF16) {
                v2u w[4][4];
#pragma unroll
                for (int q = 0; q < 4; ++q)
#pragma unroll
                    for (int j = 0; j < 4; ++j) w[q][j] = *(const v2u*)(srcB + (size_t)(r + q) * DMODEL + 4 * lane + 256 * j);
#pragma unroll
                for (int q = 0; q < 4; ++q)
#pragma unroll
                    for (int j = 0; j < 4; ++j) v[q][j] = (f32x4){__uint_as_float(w[q][j].x << 16), __uint_as_float(w[q][j].x & 0xffff0000u), __uint_as_float(w[q][j].y << 16), __uint_as_float(w[q][j].y & 0xffff0000u)};
            } else {
                const float* x0 = (r < MP ? srcP + (size_t)r * DMODEL : srcS + (size_t)(r - MP) * DMODEL) + 4 * lane;
#pragma unroll
                for (int q = 0; q < 4; ++q)
#pragma unroll
                    for (int j = 0; j < 4; ++j) v[q][j] = *(const f32x4*)(x0 + (size_t)q * DMODEL + 256 * j);
            }
#pragma unroll
            for (int q = 0; q < 4; ++q) { float s = 0.f;
#pragma unroll
                for (int j = 0; j < 4; ++j) s += (v[q][j][0] * v[q][j][0] + v[q][j][1] * v[q][j][1]) + (v[q][j][2] * v[q][j][2] + v[q][j][3] * v[q][j][3]);
                ss[q] = 1.0f / sqrtf(wave_sum(s) * (1.0f / DMODEL) + 1e-6f); }
#pragma unroll
            for (int q = 0; q < 4; ++q)
#pragma unroll
                for (int j = 0; j < 4; ++j) { const f32x4 a = v[q][j] * ss[q] * gs[j] + sh[j];
                    if (OUT_F32) *(f32x4*)(outf + (size_t)(r + q) * DMODEL + 4 * lane + 256 * j) = a;
                    else *(v2u*)(outb + (size_t)(r + q) * DMODEL + 4 * lane + 256 * j) = (v2u){pk2(a[0], a[1]), pk2(a[2], a[3])}; }
        }
    }
}
#define XB_TMO      128
#define XB_XCNT(j)  (256  + 64 * (j))
#define XB_XSUB(j)  (1280 + 64 * (j))
#define XB_XGEN(j)  (2304 + 64 * (j))
#define XB_TOP      3328
#define XB_TOPGEN   3392
#define XCD_BAR_WORDS 3456
#define XB_SPIN_CAP (1u << 18)

__device__ __forceinline__ unsigned xb_ld(unsigned* p)              { return __hip_atomic_load(p, __ATOMIC_RELAXED, __HIP_MEMORY_SCOPE_AGENT); }
__device__ __forceinline__ unsigned xb_add(unsigned* p, unsigned v) { return __hip_atomic_fetch_add(p, v, __ATOMIC_RELAXED, __HIP_MEMORY_SCOPE_AGENT); }
__device__ __forceinline__ unsigned xb_xcc_id() { return (unsigned)__builtin_amdgcn_s_getreg((3 << 11) | 20) & 0xFu; }
#define XB_SPIN(cond, bar) do { unsigned _sp = 0; while (cond) { __builtin_amdgcn_s_sleep(1); \
    if ((++_sp & 255u) == 0u) { if (xb_ld(&(bar)[XB_TMO])) break; if (_sp > XB_SPIN_CAP) { atomicAdd(&(bar)[XB_TMO], 1u); break; } } } } while (0)

struct XcdBarrier {
    unsigned* bar; unsigned x;
    volatile LAS unsigned* st;
};

__device__ __forceinline__ XcdBarrier xcd_barrier_post(unsigned* bar, volatile LAS unsigned* st, int tid) {
    XcdBarrier b; b.bar = bar; b.x = xb_xcc_id(); b.st = st;
    if (tid == 0) (void)xb_add(&bar[XB_XCNT(b.x)], 1u);
    return b;
}
__device__ __forceinline__ void xcd_barrier_complete(unsigned* bar, unsigned x, unsigned& nloc, unsigned& nx) {
    const unsigned G = gridDim.x * gridDim.y * gridDim.z;
    unsigned sum, cnt, mine, sp = 0u;
    for (;;) {
        sum = 0u; cnt = 0u; mine = 0u;
#pragma unroll
        for (unsigned j = 0; j < 16; ++j) { const unsigned c = xb_ld(&bar[XB_XCNT(j)]); sum += c; cnt += (c > 0u) ? 1u : 0u; mine = (j == x) ? c : mine; }
        if (sum == G) break;
        __builtin_amdgcn_s_sleep(1);
        if ((++sp & 255u) == 0u) { if (xb_ld(&bar[XB_TMO])) break; if (sp > XB_SPIN_CAP) { atomicAdd(&bar[XB_TMO], 1u); break; } }
    }
    nloc = mine > 0u ? mine : 1u; nx = cnt > 0u ? cnt : 1u;
}

__device__ __forceinline__ void xcd_barrier(const XcdBarrier& b, int tid) {
    asm volatile("s_waitcnt vmcnt(0)" ::: "memory");
    __syncthreads();
    if (tid == 0) {
        unsigned* bar = b.bar;
        __builtin_amdgcn_s_waitcnt(0);
        unsigned nloc = b.st[0], nx = b.st[1];
        if (nloc == 0u) { xcd_barrier_complete(bar, b.x, nloc, nx); b.st[0] = nloc; b.st[1] = nx; }
        const unsigned old = xb_add(&bar[XB_XSUB(b.x)], 1u);
        const unsigned gen = old / nloc;
        if (old + 1u == (gen + 1u) * nloc) {
            __builtin_amdgcn_fence(__ATOMIC_RELEASE, "agent");
            asm volatile("s_waitcnt vmcnt(0)" ::: "memory");
            const unsigned og = xb_add(&bar[XB_TOP], 1u);
            const unsigned tg = og / nx;
            if (og + 1u == (tg + 1u) * nx) xb_add(&bar[XB_TOPGEN], 1u);
            else XB_SPIN(xb_ld(&bar[XB_TOPGEN]) == tg, bar);
            __builtin_amdgcn_fence(__ATOMIC_ACQUIRE, "agent");
            xb_add(&bar[XB_XGEN(b.x)], 1u);
            asm volatile("s_waitcnt vmcnt(0)" ::: "memory");
        } else {
            XB_SPIN(xb_ld(&bar[XB_XGEN(b.x)]) == gen, bar);
            __builtin_amdgcn_fence(__ATOMIC_ACQUIRE, "agent");
            asm volatile("s_waitcnt vmcnt(0)" ::: "memory");
        }
    }
    __syncthreads();
}
namespace sg {
using pg8::bf16_t; using pg8::f32x4; using pg8::u32x4; using pg8::u32x2; using pg8::cvt_pk_bf16; using pg8::sigmoid_f; using pg8::silu_f; using pg8::gelu_tanh_f; using pg8::bf_lo; using pg8::bf_hi; using pg8::gate4; using pg8::ungate4;
__device__ __forceinline__ u32x2 pack4(f32x4 v) { u32x2 w; w.x = cvt_pk_bf16(v[0], v[1]); w.y = cvt_pk_bf16(v[2], v[3]); return w; }
struct SSwiglu { bf16_t* G; __device__ __forceinline__ void operator()(int row, int col, f32x4 a, f32x4 b) const { f32x4 v;
#pragma unroll
        for (int i = 0; i < 4; ++i) v[i] = silu_f(a[i]) * b[i];
        *(u32x2*)(G + (size_t)row * DFF + col) = pack4(v); } };
template <bool WF32> struct SResid { const float* baseS; float* out; const float* mod; int jmod; float mult; bf16_t* XB;
    __device__ __forceinline__ void operator()(int row, int col, f32x4 a, f32x4) const { const int b = batch_of_row(row);
        const f32x4 bs = *(const f32x4*)(baseS + (size_t)(row - MP) * DMODEL + col), mv = *(const f32x4*)(mod + (size_t)b * (NMOD * DMODEL) + jmod * DMODEL + col);
        const f32x4 o = bs + (mv + 1.0f) * mult * a;
        if (WF32) *(f32x4*)(out + (size_t)row * DMODEL + col) = o;
        *(u32x2*)(XB + (size_t)row * DMODEL + col) = pack4(o); } };
struct SIn { bf16_t *XR, *GR, *Q, *K, *V; float* dout; const float* bfgt; float qscale;
    __device__ __forceinline__ void operator()(int row, int col, f32x4 v, f32x4) const { const int rs = row - MP; const bool isfl = col >= 5120;
        const int reg = isfl ? 5 : (col >> 10), c = col & 1023; float* fdst = nullptr; f32x4 fv = v;
        if (isfl) { const f32x4 x = v + *(const f32x4*)(bfgt + (col - 5120));
#pragma unroll
            for (int i = 0; i < 4; ++i) fv[i] = fminf(x[i], 0.f) - log1pf(__expf(-fabsf(x[i])));
            fdst = dout + (size_t)203292672 + (size_t)rs * NHEAD + (col - 5120); }
        else if (reg == 3) fdst = dout + (size_t)202768384 + (size_t)rs * DMODEL + c;
        else if (reg == 4) fdst = dout + (size_t)203030528 + (size_t)rs * DMODEL + c;
        else if (reg == 0) { const int t = (rs & 15) - 13; if (t >= 0) fdst = dout + (size_t)203296768 + ((size_t)(rs >> 4) * 3 + t) * DMODEL + c; }
        if (fdst) *(f32x4*)fdst = fv;
        if (reg == 1) {
#pragma unroll
            for (int i = 0; i < 4; ++i) v[i] = gelu_tanh_f(v[i]); }
        if (reg == 2) v = v * qscale;
        bf16_t* dst = XR + (size_t)reg * ((size_t)MT * DMODEL);
        if (!isfl) *(u32x2*)(dst + (size_t)row * DMODEL + c) = pack4(v); } };
struct SGate { unsigned char *GA8, *GB8; __device__ __forceinline__ void operator()(int row, int col, f32x4 v, f32x4) const {
        *(unsigned*)((col < DMODEL ? GA8 : GB8) + (size_t)row * DMODEL + (col & 1023)) = gate4(v); } };
template <bool ADD> struct SZ { const unsigned char* GATE; bf16_t* Z; __device__ __forceinline__ void operator()(int row, int col, f32x4 v, f32x4) const { const size_t off = (size_t)row * DMODEL + col;
        v = v * ungate4(*(const unsigned*)(GATE + off));
        if (ADD) { const u32x2 z = *(const u32x2*)(Z + off); v[0] += bf_lo(z.x); v[1] += bf_hi(z.x); v[2] += bf_lo(z.y); v[3] += bf_hi(z.y); }
        *(u32x2*)(Z + off) = pack4(v); } };

template <bool DUAL, class SEpi> __device__ __forceinline__ void sample_gemm(const bf16_t* A, const bf16_t* Bt, int ncb, int K, const SEpi& E, int gw, int NGW, int lane) {
    const int li = lane & 15, g = lane >> 4, nsteps = K >> 5;
    for (int it = gw; it < 16 * ncb; it += NGW) {
        const int rb = it & 15, cb = it >> 4, c16 = 16 * cb;
        const bf16_t* ap = A + (size_t)(MP + 16 * rb + li) * K + 8 * g;
        const int brow = DUAL ? ((c16 >> 7) * 256 + (c16 & 127) + li) : (c16 + li);
        const bf16_t* bp = Bt + (size_t)brow * K + 8 * g; const bf16_t* bp3 = bp + (size_t)128 * K;
        f32x4 acc0 = (f32x4){0.f, 0.f, 0.f, 0.f}, acc1 = acc0;
#pragma unroll 8
        for (int s = 0; s < nsteps; ++s) { const pg8::bf16x8 a = *(const pg8::bf16x8*)(ap + 32 * s), b = *(const pg8::bf16x8*)(bp + 32 * s);
            acc0 = __builtin_amdgcn_mfma_f32_16x16x32_bf16(b, a, acc0, 0, 0, 0);
            if (DUAL) { const pg8::bf16x8 b3 = *(const pg8::bf16x8*)(bp3 + 32 * s); acc1 = __builtin_amdgcn_mfma_f32_16x16x32_bf16(b3, a, acc1, 0, 0, 0); } }
        E(MP + 16 * rb + li, c16 + 4 * g, acc0, acc1);
    }
}
}
typedef float f32x4m __attribute__((ext_vector_type(4)));
constexpr float LOG2E = 1.4426950408889634f;

__device__ __forceinline__ void forget_table(const float* lf, int stride, const float* tail, int ntail, LAS float* nf, LAS float* wtot, int tid, int lane, int wave) {
    float v0 = lf[(size_t)(4 * tid + 0) * stride], v1 = lf[(size_t)(4 * tid + 1) * stride], v2 = lf[(size_t)(4 * tid + 2) * stride], v3 = lf[(size_t)(4 * tid + 3) * stride];
    v1 += v0; v2 += v1; v3 += v2;
    float s = v3; int ln = lane; asm volatile("" : "+v"(ln));
#pragma unroll
    for (int o = 1; o < 64; o <<= 1) { const float t = __uint_as_float(__builtin_amdgcn_ds_bpermute(((ln - o) & 63) << 2, __float_as_uint(s))); if (ln >= o) s += t; }
    if (lane == 63) wtot[wave] = s;
    __syncthreads();
    float base = s - v3;
    for (int w = 0; w < wave; ++w) base += wtot[w];
    *(LAS f32x4m*)(nf + 4 * tid) = (f32x4m){-LOG2E * (base + v0), -LOG2E * (base + v1), -LOG2E * (base + v2), -LOG2E * (base + v3)};
    if (ntail > 0 && tid == 511) { float c = base + v3; for (int i = 0; i < ntail; ++i) { c += tail[i * 16]; nf[2048 + i] = -LOG2E * c; } }
    __syncthreads();
}

__device__ __forceinline__ void sattn_unit(const Params& P, int b, int h, LAS unsigned char* lds, int tid, int lane, int wave) {
    LAS float* nf = (LAS float*)lds;
    LAS float* wtot = (LAS float*)(lds + 8448);
    LAS float* PO = (LAS float*)(lds + 16384);
    LAS float* PM = (LAS float*)(lds + 16384 + 32768);
    LAS float* PL = PM + 128;
    const float* lf_new = P.out + O_LFS + (size_t)b * TS * NHEAD + h;
    forget_table(P.cache_logf + (size_t)b * PAST * NHEAD + h, NHEAD, lf_new, TS, nf, wtot, tid, lane, wave);
    const int li = lane & 15, g = lane >> 4;
    const bf16* qrow = (const bf16*)(P.ws + WS_Q) + (size_t)(MP + b * TS + li) * DMODEL + h * 64;
    float qf[4][4];
#pragma unroll
    for (int c = 0; c < 4; ++c) { const v2u w = *(const v2u*)(qrow + 16 * c + 4 * g); qf[c][0] = __uint_as_float(w.x << 16); qf[c][1] = __uint_as_float(w.x & 0xffff0000u); qf[c][2] = __uint_as_float(w.y << 16); qf[c][3] = __uint_as_float(w.y & 0xffff0000u); }
    const float* ck = P.cache_k + ((size_t)b * PAST * NHEAD + h) * 64; const float* cv = P.cache_v + ((size_t)b * PAST * NHEAD + h) * 64;
    const float* nk = P.out + O_KS + ((size_t)b * TS * NHEAD + h) * 64; const float* nv = P.out + O_VS + ((size_t)b * TS * NHEAD + h) * 64;
    float m = -INFINITY, l = 0.f; f32x4m o[4];
#pragma unroll
    for (int j = 0; j < 4; ++j) o[j] = (f32x4m){0.f, 0.f, 0.f, 0.f};
    const int nblk = (wave == 0) ? 17 : 16;
    f32x4m kf[4], vf[4], kg[4], vg[4];
#define SA_LOAD(KD, VD, IB) do { const bool nn_ = ((IB) == 16); const int k1_ = 16 * (16 * wave + (IB)); \
        const float* kb_ = nn_ ? nk : ck + (size_t)k1_ * (NHEAD * 64); const float* vb_ = nn_ ? nv : cv + (size_t)k1_ * (NHEAD * 64); \
        _Pragma("unroll") for (int c = 0; c < 4; ++c) KD[c] = *(const f32x4m*)(kb_ + (size_t)li * (NHEAD * 64) + 16 * c + 4 * g); \
        _Pragma("unroll") for (int i = 0; i < 4; ++i) VD[i] = *(const f32x4m*)(vb_ + (size_t)(4 * g + i) * (NHEAD * 64) + 4 * li); } while (0)
    SA_LOAD(kf, vf, 0); SA_LOAD(kg, vg, 1);
    for (int ib = 0; ib < nblk; ++ib) {
        const bool isnew = (ib == 16); const int key0 = isnew ? PAST : 16 * (16 * wave + ib);
        f32x4m kc[4], vc[4];
#pragma unroll
        for (int c = 0; c < 4; ++c) { kc[c] = kf[c]; vc[c] = vf[c]; kf[c] = kg[c]; vf[c] = vg[c]; }
        if (ib + 2 < nblk) SA_LOAD(kg, vg, ib + 2);
        f32x4m s = (f32x4m){0.f, 0.f, 0.f, 0.f};
#pragma unroll
        for (int c = 0; c < 4; ++c)
#pragma unroll
            for (int j = 0; j < 4; ++j) s = __builtin_amdgcn_mfma_f32_16x16x4f32(kc[c][j], qf[c][j], s, 0, 0, 0);
        const f32x4m nb = *(const LAS f32x4m*)(nf + key0 + 4 * g);
        s = s + nb;
        if (isnew) {
#pragma unroll
            for (int r = 0; r < 4; ++r) if (4 * g + r > li) s[r] = -INFINITY; }
        float bm = fmaxf(fmaxf(s[0], s[1]), fmaxf(s[2], s[3]));
        bm = fmaxf(bm, __shfl_xor(bm, 16)); bm = fmaxf(bm, __shfl_xor(bm, 32));
        const float mn = fmaxf(m, bm), alpha = __builtin_amdgcn_exp2f(m - mn);
        float p[4];
#pragma unroll
        for (int r = 0; r < 4; ++r) p[r] = __builtin_amdgcn_exp2f(s[r] - mn);
        l = l * alpha + ((p[0] + p[1]) + (p[2] + p[3])); m = mn;
#pragma unroll
        for (int r = 0; r < 4; ++r) { const float ar = __shfl(alpha, 4 * g + r);
#pragma unroll
            for (int j = 0; j < 4; ++j) o[j][r] *= ar; }
#pragma unroll
        for (int i = 0; i < 4; ++i)
#pragma unroll
            for (int j = 0; j < 4; ++j) o[j] = __builtin_amdgcn_mfma_f32_16x16x4f32(p[i], vc[i][j], o[j], 0, 0, 0);
    }
#undef SA_LOAD
    l += __shfl_xor(l, 16); l += __shfl_xor(l, 32);
    if (g == 0) { PM[wave * 16 + li] = m; PL[wave * 16 + li] = l; }
#pragma unroll
    for (int r = 0; r < 4; ++r) *(LAS f32x4m*)(PO + (wave * 16 + 4 * g + r) * 64 + 4 * li) = (f32x4m){o[0][r], o[1][r], o[2][r], o[3][r]};
    __syncthreads();
    {   const int q = tid >> 5, d = 2 * (tid & 31); float M = -INFINITY;
#pragma unroll
        for (int w = 0; w < 8; ++w) M = fmaxf(M, PM[w * 16 + q]);
        float den = 0.f, n0 = 0.f, n1 = 0.f;
#pragma unroll
        for (int w = 0; w < 8; ++w) { const float f = __builtin_amdgcn_exp2f(PM[w * 16 + q] - M); den += f * PL[w * 16 + q]; n0 += f * PO[(w * 16 + q) * 64 + d]; n1 += f * PO[(w * 16 + q) * 64 + d + 1]; }
        const float inv = 1.0f / den;
        *(unsigned*)((bf16*)(P.ws + WS_Q) + (size_t)(MP + b * TS + q) * DMODEL + h * 64 + d) = pk2(n0 * inv, n1 * inv); }
    __syncthreads();
}

__device__ __forceinline__ void rglru_item(const Params& P, int row_base, int T, int n, const float* tail0, const float* h0, float* hlast, LAS unsigned char* lds, int tid, int lane, int wave) {
    LAS float* XS = (LAS float*)lds;
    LAS float* XC = (LAS float*)(lds + 33792);
    LAS float* AA = (LAS float*)(lds + 66560);
    LAS bf16* XCB = (LAS bf16*)(lds + 99328);
    LAS float* AH = (LAS float*)(lds + 117760);
    LAS bf16* GRS = (LAS bf16*)(lds + 121856);
    const int c0 = 64 * n, li = lane & 15, g = lane >> 4;
    const bf16* XR = (const bf16*)(P.ws + WS_XR); bf16* GR = (bf16*)(P.ws + WS_GR);
    const int cc = tid & 63, tr = tid >> 6;
    const float cw0 = P.conv_w[0 * DMODEL + c0 + cc], cw1 = P.conv_w[1 * DMODEL + c0 + cc], cw2 = P.conv_w[2 * DMODEL + c0 + cc], cw3 = P.conv_w[3 * DMODEL + c0 + cc], cbv = P.conv_b[c0 + cc];
    float gba[4], gbx[4], gsp[4];
#pragma unroll
    for (int ct = 0; ct < 4; ++ct) { const int c = c0 + 16 * ct + li; gba[ct] = P.rg_ba[c]; gbx[ct] = P.rg_bx[c]; const float lam = P.rg_lam[c];
        const float sp = (lam < -15.f) ? -lam : log1pf(__expf(-lam)); gsp[ct] = -8.0f * sp; }
    bf16x8 wfa[4][2], wfx[4][2];
    { const bf16* RGW = (const bf16*)(P.ws + WS_RGW) + n * 4096;
#pragma unroll
      for (int ct = 0; ct < 4; ++ct)
#pragma unroll
        for (int s = 0; s < 2; ++s) { wfa[ct][s] = *(const bf16x8*)(RGW + (16 * ct + li) * 64 + 32 * s + 8 * g); wfx[ct][s] = *(const bf16x8*)(RGW + 65536 + (16 * ct + li) * 64 + 32 * s + 8 * g); } }
    float hc = h0 ? h0[c0 + lane] : 0.f;
    const int nchunk = (T + 127) / 128;
    const int prow0 = tid >> 3, pc8 = (tid & 7) * 8;
    v4u xpre[2], gpre[2];
#pragma unroll
    for (int i = 0; i < 2; ++i) { const int row = prow0 + 64 * i; xpre[i] = (v4u){0u, 0u, 0u, 0u}; gpre[i] = xpre[i];
        if (row < T) { const size_t o = (size_t)(row_base + row) * DMODEL + c0 + pc8; xpre[i] = *(const v4u*)(XR + o); gpre[i] = *(const v4u*)(GR + o); } }
    for (int ch = 0; ch < nchunk; ++ch) {
        const int t0 = ch * 128, nvalid = (T - t0) < 128 ? (T - t0) : 128;
        float tv = 0.f;
        if (tid < 192) { if (ch == 0) tv = tail0 ? tail0[(size_t)(tid >> 6) * DMODEL + c0 + (tid & 63)] : 0.f; else tv = XS[(128 + (tid >> 6)) * 64 + (tid & 63)]; }
        __syncthreads();
        if (tid < 192) XS[(tid >> 6) * 64 + (tid & 63)] = tv;
#pragma unroll
        for (int i = 0; i < 2; ++i) { const int row = prow0 + 64 * i; const v4u w = xpre[i];
            LAS float* d = XS + (3 + row) * 64 + pc8;
            *(LAS f32x4m*)d = (f32x4m){__uint_as_float(w.x << 16), __uint_as_float(w.x & 0xffff0000u), __uint_as_float(w.y << 16), __uint_as_float(w.y & 0xffff0000u)};
            *(LAS f32x4m*)(d + 4) = (f32x4m){__uint_as_float(w.z << 16), __uint_as_float(w.z & 0xffff0000u), __uint_as_float(w.w << 16), __uint_as_float(w.w & 0xffff0000u)};
            *(LAS v4u*)(GRS + row * 64 + pc8) = gpre[i]; }
        if (ch + 1 < nchunk) {
#pragma unroll
            for (int i = 0; i < 2; ++i) { const int row = t0 + 128 + prow0 + 64 * i; xpre[i] = (v4u){0u, 0u, 0u, 0u}; gpre[i] = xpre[i];
                if (row < T) { const size_t o = (size_t)(row_base + row) * DMODEL + c0 + pc8; xpre[i] = *(const v4u*)(XR + o); gpre[i] = *(const v4u*)(GR + o); } } }
        __syncthreads();
#pragma unroll 4
        for (int i = 0; i < 16; ++i) { const int t = 16 * tr + i;
            const float y = cbv + (cw0 * XS[t * 64 + cc] + cw1 * XS[(t + 1) * 64 + cc]) + (cw2 * XS[(t + 2) * 64 + cc] + cw3 * XS[(t + 3) * 64 + cc]);
            XC[t * 64 + cc] = y; XCB[t * 72 + cc] = (bf16)f2bf(y); }
        { bf16x8 af[2];
#pragma unroll
          for (int s = 0; s < 2; ++s) af[s] = *(const LAS bf16x8*)(XCB + (16 * wave + li) * 72 + 32 * s + 8 * g);
#pragma unroll
          for (int ct = 0; ct < 4; ++ct) { f32x4m pa = (f32x4m){0.f, 0.f, 0.f, 0.f}, px = pa;
#pragma unroll
            for (int s = 0; s < 2; ++s) { pa = __builtin_amdgcn_mfma_f32_16x16x32_bf16(af[s], wfa[ct][s], pa, 0, 0, 0); px = __builtin_amdgcn_mfma_f32_16x16x32_bf16(af[s], wfx[ct][s], px, 0, 0, 0); }
#pragma unroll
            for (int r = 0; r < 4; ++r) { const int t = 16 * wave + 4 * g + r, c = 16 * ct + li;
                const float rr = pg8::sigmoid_f(pa[r] + gba[ct]), ii = pg8::sigmoid_f(px[r] + gbx[ct]);
                const float la = gsp[ct] * rr, a = __expf(la);
                const float om = (1.0f - a) * (1.0f + a);
                const float u = sqrtf(om) * ii * XC[t * 64 + c];
                AA[t * 64 + c] = a; XC[t * 64 + c] = u; } } }
        { float A = 1.f, H = 0.f;
#pragma unroll
          for (int tt = 0; tt < 16; ++tt) { const float a = AA[(16 * wave + tt) * 64 + lane], u = XC[(16 * wave + tt) * 64 + lane]; H = a * H + u; A *= a; }
          AH[(wave * 2 + 0) * 64 + lane] = A; AH[(wave * 2 + 1) * 64 + lane] = H; }
        __syncthreads();
        { const int nvw = nvalid >> 4; float hin = hc, hend = hc;
#pragma unroll
          for (int w = 0; w < 8; ++w) { const float A = AH[(w * 2) * 64 + lane], H = AH[(w * 2 + 1) * 64 + lane]; if (w < wave) hin = A * hin + H; if (w < nvw) hend = A * hend + H; }
          if (wave < nvw) { float h = hin;
#pragma unroll
            for (int tt = 0; tt < 16; ++tt) { const int t = 16 * wave + tt; const float a = AA[t * 64 + lane], u = XC[t * 64 + lane]; h = a * h + u;
                GRS[t * 64 + lane] = (bf16)f2bf(h * bf2f(GRS[t * 64 + lane])); } }
          if (wave < nvw) { const int row = 16 * wave + (lane >> 2), cp = (lane & 3) * 16;
#pragma unroll
            for (int i = 0; i < 2; ++i) *(v4u*)(GR + (size_t)(row_base + t0 + row) * DMODEL + c0 + cp + 8 * i) = *(const LAS v4u*)(GRS + row * 64 + cp + 8 * i); }
          hc = hend; }
    }
    if (wave == 0) hlast[c0 + lane] = hc;
    __syncthreads();
}
#ifndef MK_SPLIT
#define MK_SPLIT 0
#endif
__global__ void __launch_bounds__(NWAVES * 64, 2) fwd_megakernel(Params P) {
    extern __shared__ __attribute__((aligned(16))) unsigned char lds_raw[];
    LAS unsigned char* lds = (LAS unsigned char*)lds_raw;
    const int G = gridDim.x;
    const int wave0 = __builtin_amdgcn_readfirstlane(threadIdx.x >> 6);
#define TID_DEFS int tid_; asm volatile("v_mbcnt_lo_u32_b32 %0, -1, 0\n\tv_mbcnt_hi_u32_b32 %0, -1, %0" : "=v"(tid_)); tid_ += wave0 * 64; const int tid = tid_, lane = tid & 63, wave = __builtin_amdgcn_readfirstlane(tid >> 6); (void)lane; (void)wave
    cg::grid_group grid = cg::this_grid();
    unsigned char* ws = P.ws;
    bf16* HN = (bf16*)(ws + WS_HN); bf16* XR = (bf16*)(ws + WS_XR); bf16* GR = (bf16*)(ws + WS_GR); bf16* QB = (bf16*)(ws + WS_Q); bf16* KB = (bf16*)(ws + WS_K); bf16* VB = (bf16*)(ws + WS_V); bf16* GB = (bf16*)(ws + WS_G);
    const float* MOD = (const float*)(ws + WS_MOD); const float* MODF = (const float*)(ws + WS_MODF);
    unsigned char* GA8 = ws + WS_END; unsigned char* GB8 = ws + WS_END + (size_t)MT * DMODEL;
    float* X = P.out + O_Y;
#ifdef PH_ONLY
#define IN(k) ((k) == PH_ONLY)
#else
#define IN(k) (P.ph_lo <= (k) && (k) < P.ph_hi)
#endif
#define STAMP(k) do {} while (0)
#define SEAM(k) do { if (IN(k) && IN((k) + 1)) { { TID_DEFS; xcd_barrier(bar, tid); } } STAMP(k); } while (0)
    if (P.ph_lo < 0) grid.sync();
    XcdBarrier bar;
    { TID_DEFS; for (int u = tid; u < 64; u += NWAVES * 64) ((LAS unsigned*)(lds + LDS_BYTES - 256))[u] = 0u; __syncthreads();
      bar = xcd_barrier_post((unsigned*)(ws + WS_CTL), (volatile LAS unsigned*)(lds + LDS_BYTES - 256) + 8, tid); }
#define GEMM_PHASE(EPI, e, Aptr, Bptr, NN, KK) do { pg8::Gemm g_{(const pg8::bf16_t*)(Aptr), (const pg8::bf16_t*)(Bptr), MP, (NN), (KK)}; pg8::StaticOrder S_; S_.init(MP, (NN), G, (int)blockIdx.x); \
        TID_DEFS; pg8::gemm_phase<EPI, pg8::StaticOrder, true, true>(lds, g_, S_, e, tid); } while (0)

#define SAMPLE_GEMM(DUAL, se, Aptr, Bptr, NCB, KK) do { TID_DEFS; sg::sample_gemm<DUAL>((const pg8::bf16_t*)(Aptr), (const pg8::bf16_t*)(Bptr), (NCB), (KK), se, (int)blockIdx.x * NWAVES + wave, G * NWAVES, lane); } while (0)
    constexpr int P0_SPLIT = 5632;
    if (IN(0)) { TID_DEFS; p0_ada(P, lds, wave, lane, tid); if ((int)blockIdx.x >= 176 && G > 176) p0_prologue(P, lds, wave, lane, tid, 0, P0_SPLIT, ((int)blockIdx.x - 176) * NWAVES + wave, (G - 176) * NWAVES); } SEAM(0);
    if (IN(1)) { TID_DEFS; p0_prologue(P, lds, wave, lane, tid, (G > 176) ? P0_SPLIT : 0, 1 << 30, (int)blockIdx.x * NWAVES + wave, G * NWAVES); norm_phase<false, false>(P.x_prompt, P.x_sample, nullptr, P.ffn1_norm, MOD, NMOD * DMODEL, 0, 1, HN, nullptr, wave, lane); } SEAM(1);
    if (IN(2)) { pg8::EpiSwiglu e{GB}; GEMM_PHASE(pg8::EpiSwiglu, e, HN, ws + WS_W13A, 2 * DFF, DMODEL); sg::SSwiglu se{GB}; SAMPLE_GEMM(true, se, HN, ws + WS_W13A, DFF / 16, DMODEL); } SEAM(2);
    if (IN(3)) { pg8::EpiResid<true> e{P.x_prompt, X, MOD, 2, 0.5f, HN}; GEMM_PHASE(pg8::EpiResid<true>, e, GB, ws + WS_W2A, DMODEL, DFF); sg::SResid<true> se{P.x_sample, X, MOD, 2, 0.5f, HN}; SAMPLE_GEMM(false, se, GB, ws + WS_W2A, DMODEL / 16, DFF); } SEAM(3);
    if (IN(4)) { TID_DEFS; norm_phase<false, true>(nullptr, nullptr, HN, P.mix_norm, MOD, NMOD * DMODEL, 3, 4, HN, nullptr, wave, lane); } SEAM(4);
    if (IN(5)) { pg8::EpiIn e{XR, GR, QB, KB, VB, P.out, P.b_fgt, attn_body::C2, GA8, GB8}; GEMM_PHASE(pg8::EpiIn, e, HN, ws + WS_WIN, 29 * 256, DMODEL); sg::SIn se{XR, GR, QB, KB, VB, P.out, P.b_fgt, attn_body::C2}; SAMPLE_GEMM(false, se, HN, ws + WS_WIN, 5136 / 16, DMODEL);
        sg::SGate sgt{GA8, GB8}; SAMPLE_GEMM(false, sgt, HN, ws + WS_WIN + (size_t)5376 * DMODEL * 2, 2048 / 16, DMODEL); } SEAM(5);

    if (IN(6)) {
#ifndef NO_ATTN
        for (int bh = blockIdx.x; bh < NB_P * NHEAD; bh += G) { TID_DEFS; const int b = bh >> 4, h = bh & 15;
            forget_table(P.out + O_LFP + (size_t)b * SEQ_P * NHEAD + h, NHEAD, nullptr, 0, (LAS float*)(lds + attn_body::LDS_NF), (LAS float*)(lds + attn_body::LDS_NFW), tid, lane, wave);
            for (int qb = 7; qb >= 0; --qb) attn_body::attn_unit<16>(b, h, qb, (const attn_body::bf16*)QB, (const attn_body::bf16*)KB, (const attn_body::bf16*)VB, (attn_body::bf16*)QB, (char*)lds_raw, tid);
            __syncthreads(); }
#endif
#ifndef NO_SATTN
        for (int u = blockIdx.x; u < NB_S * NHEAD; u += G) { TID_DEFS; sattn_unit(P, u >> 4, u & 15, lds, tid, lane, wave); }
#endif
#ifndef NO_RGLRU
        for (int it = blockIdx.x; it < NB_P * 16; it += G) { TID_DEFS; const int b = it >> 4, n = it & 15; rglru_item(P, b * SEQ_P, SEQ_P, n, nullptr, nullptr, P.out + O_HP + (size_t)b * DMODEL, lds, tid, lane, wave); }
        for (int it = blockIdx.x; it < NB_S * 16; it += G) { TID_DEFS; const int b = it >> 4, n = it & 15;
            rglru_item(P, MP + b * TS, TS, n, P.state_conv + (size_t)b * 3 * DMODEL, P.state_rglru + (size_t)b * DMODEL, P.out + O_HS + (size_t)b * DMODEL, lds, tid, lane, wave); }
#endif
    } SEAM(6);

    if (IN(8)) { pg8::EpiZ<false> e{GA8, VB}; GEMM_PHASE(pg8::EpiZ<false>, e, GR, ws + WS_WR, DMODEL, DMODEL); sg::SZ<false> se{GA8, VB}; SAMPLE_GEMM(false, se, GR, ws + WS_WR, DMODEL / 16, DMODEL); }
    if (IN(9)) { pg8::EpiZ<true> e{GB8, VB}; GEMM_PHASE(pg8::EpiZ<true>, e, QB, ws + WS_WA, DMODEL, DMODEL); sg::SZ<true> se{GB8, VB}; SAMPLE_GEMM(false, se, QB, ws + WS_WA, DMODEL / 16, DMODEL); } SEAM(9);
    if (IN(10)) { pg8::EpiResid<true> e{X, X, MOD, 5, 1.0f, HN}; GEMM_PHASE(pg8::EpiResid<true>, e, VB, ws + WS_WO, DMODEL, DMODEL); sg::SResid<true> se{X + (size_t)MP * DMODEL, X, MOD, 5, 1.0f, HN}; SAMPLE_GEMM(false, se, VB, ws + WS_WO, DMODEL / 16, DMODEL); } SEAM(10);
    if (IN(11)) { TID_DEFS; norm_phase<false, true>(nullptr, nullptr, HN, P.ffn2_norm, MOD, NMOD * DMODEL, 6, 7, HN, nullptr, wave, lane); } SEAM(11);
    if (IN(12)) { pg8::EpiSwiglu e{GB}; GEMM_PHASE(pg8::EpiSwiglu, e, HN, ws + WS_W13B, 2 * DFF, DMODEL); sg::SSwiglu se{GB}; SAMPLE_GEMM(true, se, HN, ws + WS_W13B, DFF / 16, DMODEL); } SEAM(12);
    if (IN(13)) { pg8::EpiResid<false> e{X, X, MOD, 8, 0.5f, HN}; GEMM_PHASE(pg8::EpiResid<false>, e, GB, ws + WS_W2B, DMODEL, DFF); sg::SResid<false> se{X + (size_t)MP * DMODEL, X, MOD, 8, 0.5f, HN}; SAMPLE_GEMM(false, se, GB, ws + WS_W2B, DMODEL / 16, DFF); } SEAM(13);
    if (IN(14)) { TID_DEFS; norm_phase<true, true>(nullptr, nullptr, HN, P.final_norm, MODF, 2 * DMODEL, 0, 1, nullptr, X, wave, lane); }

#undef IN
#undef SEAM
#undef GEMM_PHASE
#undef SAMPLE_GEMM
}

extern "C" void kernel_launch(void* const* d_in, const int* in_sizes, int n_in, void* d_out, int out_size, void* d_ws, size_t ws_size, hipStream_t stream) {
    static int grid = 0;
    if (grid == 0) {
        if (n_in != 35 || ws_size < WS_END) { fprintf(stderr, "kernel_launch: unexpected n_in %d / ws %zu\n", n_in, ws_size); grid = -1; return; }
        int dev = 0, cus = 0, per_cu = 0;
        hipGetDevice(&dev); hipDeviceGetAttribute(&cus, hipDeviceAttributeMultiprocessorCount, dev);
        if (hipFuncSetAttribute((const void*)fwd_megakernel, hipFuncAttributeMaxDynamicSharedMemorySize, LDS_BYTES) != hipSuccess) { fprintf(stderr, "kernel_launch: hipFuncSetAttribute failed\n"); grid = -1; return; }
        if (hipOccupancyMaxActiveBlocksPerMultiprocessor(&per_cu, (const void*)fwd_megakernel, NWAVES * 64, LDS_BYTES) != hipSuccess || per_cu < 1) { fprintf(stderr, "kernel_launch: occupancy query says %d\n", per_cu); per_cu = 1; }
        (void)hipGetLastError();
        grid = cus;
    }
    if (grid < 0) return;
    if (hipMemsetAsync((char*)d_ws + WS_CTL, 0, 65536, stream) != hipSuccess) { fprintf(stderr, "kernel_launch: memset failed\n"); return; }
    Params p{};
    const float** pp = (const float**)&p;
    for (int i = 0; i < 35; ++i) pp[i] = (const float*)d_in[i];
    p.out = (float*)d_out; p.ws = (unsigned char*)d_ws;
#if MK_SPLIT
    for (int ph = 0; ph < NPHASE; ++ph) { p.ph_lo = ph; p.ph_hi = ph + 1; void* args[] = {&p};
        hipError_t e = hipLaunchCooperativeKernel((const void*)fwd_megakernel, dim3(grid), dim3(NWAVES * 64), args, LDS_BYTES, stream);
        if (e != hipSuccess) { fprintf(stderr, "cooperative launch (phase %d) failed: %s\n", ph, hipGetErrorString(e)); break; } }
#else
    p.ph_lo = 0; p.ph_hi = NPHASE; void* args[] = {&p};
    hipError_t e = hipLaunchCooperativeKernel((const void*)fwd_megakernel, dim3(grid), dim3(NWAVES * 64), args, LDS_BYTES, stream);
    if (e != hipSuccess) fprintf(stderr, "cooperative launch failed: %s (grid %d)\n", hipGetErrorString(e), grid);
#endif
}
```
